# Optimizing an MI355X kernel written in HIP

```python
import math
import jax, jax.numpy as jnp
from jax import lax
import numpy as np

D_MODEL = 1024
BATCH = 16
SEQ = 4096
DEPTH = 1
DEC_BATCH = 8
DEC_SEQ = 32
PAST_LEN = 4096

CHUNK = 64
Q_BLOCK = 128
HEAD_DIM = 64
FOX_HEADS = 8
DSA_HEADS = 8
DSA_KV_HEADS = 2
IDX_HEADS = 4
IDX_DIM = 64
IDX_TOPK_MAX = 256
ROPE_THETA = 500000.0
ROT_DIM = HEAD_DIM // 4
FOX_WIDTH = FOX_HEADS * HEAD_DIM
DSA_WIDTH = DSA_HEADS * HEAD_DIM
DSA_KV_WIDTH = DSA_KV_HEADS * HEAD_DIM
MIX_WIDTH = FOX_WIDTH + DSA_WIDTH
D_FF = -(-8 * D_MODEL // (3 * 256)) * 256
ALPHA = (2 * DEPTH) ** 0.25
BETA = (8 * DEPTH) ** -0.25
LN_EPS = 1e-5
FORGET_BIAS_INIT = 3.0
IN_SIZES = (FOX_WIDTH, FOX_WIDTH, FOX_WIDTH, FOX_HEADS,
            DSA_WIDTH, DSA_KV_WIDTH, DSA_KV_WIDTH, IDX_HEADS * IDX_DIM, IDX_DIM, IDX_HEADS)
IN_WIDTH = sum(IN_SIZES)
IN_VALUE_PARTS = (2, 6)

kernel_name = "fox_dsa_hybrid_stream_step"


def layer_norm(x, g, b):
    xf = x.astype(jnp.float32)
    mu = jnp.mean(xf, -1, keepdims=True)
    var = jnp.mean(jnp.square(xf - mu), -1, keepdims=True)
    return ((xf - mu) * lax.rsqrt(var + LN_EPS) * g + b).astype(x.dtype)


def rope_tables(positions):
    half = ROT_DIM // 2
    inv_freq = ROPE_THETA ** (-jnp.arange(half, dtype=jnp.float32) * 2.0 / ROT_DIM)
    ang = positions.astype(jnp.float32)[:, None] * inv_freq[None, :]
    return jnp.cos(ang), jnp.sin(ang)


def partial_rope(x, cos, sin):
    half = ROT_DIM // 2
    x1, x2 = x[..., :half], x[..., half:ROT_DIM]
    cos = cos.astype(x.dtype)
    sin = sin.astype(x.dtype)
    return jnp.concatenate([x1 * cos - x2 * sin, x2 * cos + x1 * sin, x[..., ROT_DIM:]], axis=-1)


def project_inputs(x, positions, w_in, b_forget):
    B, S, _ = x.shape
    points, acc = [], 0
    for size in IN_SIZES[:-1]:
        acc += size
        points.append(acc)
    fq, fk, fv, ff, dq, dk, dv, iq, ik, iw = jnp.split(x @ w_in, points, axis=-1)
    cos, sin = rope_tables(positions)
    c4, s4 = cos[None, :, None, :], sin[None, :, None, :]
    fox_q = fq.reshape(B, S, FOX_HEADS, HEAD_DIM)
    fox_k = fk.reshape(B, S, FOX_HEADS, HEAD_DIM)
    fox_v = fv.reshape(B, S, FOX_HEADS, HEAD_DIM)
    fox_logf = jax.nn.log_sigmoid((ff + b_forget).astype(jnp.float32))
    dsa_q = partial_rope(dq.reshape(B, S, DSA_HEADS, HEAD_DIM), c4, s4)
    dsa_k = partial_rope(dk.reshape(B, S, DSA_KV_HEADS, HEAD_DIM), c4, s4)
    dsa_v = dv.reshape(B, S, DSA_KV_HEADS, HEAD_DIM)
    idx_q = partial_rope(iq.reshape(B, S, IDX_HEADS, IDX_DIM), c4, s4)
    idx_k = partial_rope(ik, cos[None], sin[None])
    return fox_q, fox_k, fox_v, fox_logf, dsa_q, dsa_k, dsa_v, idx_q, idx_k, iw


def fox_prompt(q, k, v, logf):
    B, S, H, Dh = q.shape
    ct = jnp.cumsum(logf, axis=1).transpose(0, 2, 1)
    kpos = jnp.arange(S)
    scale = Dh ** -0.5

    def block(i):
        start = i * Q_BLOCK
        qb = lax.dynamic_slice_in_dim(q, start, Q_BLOCK, axis=1)
        cq = lax.dynamic_slice_in_dim(ct, start, Q_BLOCK, axis=2)
        s = jnp.einsum('bqhd,bshd->bhqs', qb, k).astype(jnp.float32) * scale
        s = s + cq[..., None] - ct[:, :, None, :]
        qpos = start + jnp.arange(Q_BLOCK)
        s = jnp.where(kpos[None, :] <= qpos[:, None], s, -jnp.inf)
        p = jax.nn.softmax(s, axis=-1).astype(v.dtype)
        return jnp.einsum('bhqs,bshd->bqhd', p, v)

    out = lax.map(block, jnp.arange(S // Q_BLOCK))
    return jnp.moveaxis(out, 0, 1).reshape(B, S, H * Dh)


def fox_sample(q, k_new, v_new, lf_new, k_past, v_past, lf_past):
    B, T, H, Dh = q.shape
    P = k_past.shape[1]
    k = jnp.concatenate([k_past, k_new], axis=1)
    v = jnp.concatenate([v_past, v_new], axis=1)
    lp = lf_past.astype(jnp.float32)
    d_past = lax.cumsum(lp, axis=1, reverse=True) - lp
    c_new = jnp.cumsum(lf_new.astype(jnp.float32), axis=1)
    key_bias = jnp.concatenate([d_past, -c_new], axis=1)
    s = jnp.einsum('bqhd,bshd->bhqs', q, k).astype(jnp.float32) * Dh ** -0.5
    s = s + c_new.transpose(0, 2, 1)[..., None] + key_bias.transpose(0, 2, 1)[:, :, None, :]
    kpos = jnp.arange(P + T)
    qpos = P + jnp.arange(T)
    s = jnp.where(kpos[None, :] <= qpos[:, None], s, -jnp.inf)
    p = jax.nn.softmax(s, axis=-1).astype(v.dtype)
    return jnp.einsum('bhqs,bshd->bqhd', p, v).reshape(B, T, H * Dh)


def gathered_attention(q, k, v, idx, valid):
    B, Q, H, Dh = q.shape
    KVH = k.shape[2]
    gather = jax.vmap(lambda t, i: t[i])
    ks = gather(k, idx)
    vs = gather(v, idx)
    qg = q.reshape(B, Q, KVH, H // KVH, Dh)
    s = jnp.einsum('bqhgd,bqnhd->bqhgn', qg, ks).astype(jnp.float32) * Dh ** -0.5
    s = jnp.where(valid[:, :, None, None, :], s, -jnp.inf)
    p = jax.nn.softmax(s, axis=-1).astype(v.dtype)
    return jnp.einsum('bqhgn,bqnhd->bqhgd', p, vs).reshape(B, Q, H * Dh)


def dsa_select_attend(q, iq, iw, q_pos, k, v, ik, k_pos, top_k):
    logits = jnp.einsum('bqhd,bsd->bqhs', iq, ik)
    score = jnp.einsum('bqh,bqhs->bqs', iw, jax.nn.relu(logits)).astype(jnp.float32)
    q_chunk = q_pos // CHUNK
    adm = (k_pos[None, :] // CHUNK) <= q_chunk[:, None]
    score = jnp.where(adm[None], score, -jnp.inf)
    _, idx = lax.top_k(score, top_k)
    valid = (k_pos[idx] // CHUNK) <= q_chunk[None, :, None]
    return gathered_attention(q, k, v, idx, valid)


def dsa_prompt(q, iq, iw, k, v, ik, top_k):
    B, S = q.shape[:2]
    kpos = jnp.arange(S)

    def block(i):
        start = i * Q_BLOCK
        sl = lambda t: lax.dynamic_slice_in_dim(t, start, Q_BLOCK, axis=1)
        return dsa_select_attend(sl(q), sl(iq), sl(iw), start + jnp.arange(Q_BLOCK), k, v, ik, kpos, top_k)

    out = lax.map(block, jnp.arange(S // Q_BLOCK))
    return jnp.moveaxis(out, 0, 1).reshape(B, S, -1)


def post_sublayers(x, mix, ln1_g, ln1_b, w_gate, w_up, w_down, ln2_g, ln2_b):
    h = layer_norm(ALPHA * x + mix, ln1_g, ln1_b)
    f = (jax.nn.silu(h @ w_gate) * (h @ w_up)) @ w_down
    return layer_norm(ALPHA * h + f, ln2_g, ln2_b)


def setup_inputs(seed: int = 0) -> dict:
    key = jax.random.key(seed)
    ks = jax.random.split(key, 20)
    f32 = jnp.float32
    n = lambda k, s: jax.random.normal(k, s, f32)
    x_prompt = n(ks[0], (BATCH, SEQ, D_MODEL))
    x_sample = n(ks[1], (DEC_BATCH, DEC_SEQ, D_MODEL))
    cache_fox_k = n(ks[2], (DEPTH, DEC_BATCH, PAST_LEN, FOX_HEADS, HEAD_DIM))
    cache_fox_v = n(ks[3], (DEPTH, DEC_BATCH, PAST_LEN, FOX_HEADS, HEAD_DIM)) * BETA
    cache_fox_logf = jax.nn.log_sigmoid(FORGET_BIAS_INIT + n(ks[4], (DEPTH, DEC_BATCH, PAST_LEN, FOX_HEADS)))
    cache_dsa_k = n(ks[5], (DEPTH, DEC_BATCH, PAST_LEN, DSA_KV_HEADS, HEAD_DIM))
    cache_dsa_v = n(ks[6], (DEPTH, DEC_BATCH, PAST_LEN, DSA_KV_HEADS, HEAD_DIM)) * BETA
    cache_idx_k = n(ks[7], (DEPTH, DEC_BATCH, PAST_LEN, IDX_DIM))
    col_scale = jnp.concatenate([jnp.full((sz,), BETA if i in IN_VALUE_PARTS else 1.0, f32)
                                 for i, sz in enumerate(IN_SIZES)])
    w_in = n(ks[8], (DEPTH, D_MODEL, IN_WIDTH)) * D_MODEL ** -0.5 * col_scale
    b_forget = FORGET_BIAS_INIT + 0.5 * n(ks[9], (DEPTH, FOX_HEADS))
    w_out = n(ks[10], (DEPTH, MIX_WIDTH, D_MODEL)) * MIX_WIDTH ** -0.5 * BETA
    ln1_g = 1.0 + 0.05 * n(ks[11], (DEPTH, D_MODEL))
    ln1_b = 0.02 * n(ks[12], (DEPTH, D_MODEL))
    w_gate = n(ks[13], (DEPTH, D_MODEL, D_FF)) * D_MODEL ** -0.5
    w_up = n(ks[14], (DEPTH, D_MODEL, D_FF)) * D_MODEL ** -0.5 * BETA
    w_down = n(ks[15], (DEPTH, D_FF, D_MODEL)) * D_FF ** -0.5 * BETA
    ln2_g = 1.0 + 0.05 * n(ks[16], (DEPTH, D_MODEL))
    ln2_b = 0.02 * n(ks[17], (DEPTH, D_MODEL))
    return {"x_prompt": x_prompt, "x_sample": x_sample,
            "cache_fox_k": cache_fox_k, "cache_fox_v": cache_fox_v, "cache_fox_logf": cache_fox_logf,
            "cache_dsa_k": cache_dsa_k, "cache_dsa_v": cache_dsa_v, "cache_idx_k": cache_idx_k,
            "w_in": w_in, "b_forget": b_forget, "w_out": w_out, "ln1_g": ln1_g, "ln1_b": ln1_b,
            "w_gate": w_gate, "w_up": w_up, "w_down": w_down, "ln2_g": ln2_g, "ln2_b": ln2_b}


def reference(x_prompt, x_sample, cache_fox_k, cache_fox_v, cache_fox_logf, cache_dsa_k, cache_dsa_v,
              cache_idx_k, w_in, b_forget, w_out, ln1_g, ln1_b, w_gate, w_up, w_down, ln2_g, ln2_b):
    S = x_prompt.shape[1]
    T = x_sample.shape[1]
    P = cache_fox_k.shape[2]
    topk_prompt = min(IDX_TOPK_MAX, S // 4)
    topk_sample = min(IDX_TOPK_MAX, (P + T) // 4)
    pos_p = jnp.arange(S)
    pos_s = P + jnp.arange(T)
    kpos_s = jnp.arange(P + T)
    yp, ys = x_prompt, x_sample
    p_st = [[] for _ in range(6)]
    s_st = [[] for _ in range(6)]
    for l in range(DEPTH):
        fq, fk, fv, flf, dq, dk, dv, iq, ik, iw = project_inputs(yp, pos_p, w_in[l], b_forget[l])
        fox_o = fox_prompt(fq, fk, fv, flf)
        dsa_o = dsa_prompt(dq, iq, iw, dk, dv, ik, topk_prompt)
        mix = jnp.concatenate([fox_o, dsa_o], axis=-1) @ w_out[l]
        yp = post_sublayers(yp, mix, ln1_g[l], ln1_b[l], w_gate[l], w_up[l], w_down[l], ln2_g[l], ln2_b[l])
        for lst, arr in zip(p_st, (fk, fv, flf, dk, dv, ik)):
            lst.append(arr)
        gq, gk, gv, glf, eq, ek, ev, jq, jk, jw = project_inputs(ys, pos_s, w_in[l], b_forget[l])
        fox_s = fox_sample(gq, gk, gv, glf, cache_fox_k[l], cache_fox_v[l], cache_fox_logf[l])
        k_all = jnp.concatenate([cache_dsa_k[l], ek], axis=1)
        v_all = jnp.concatenate([cache_dsa_v[l], ev], axis=1)
        ik_all = jnp.concatenate([cache_idx_k[l], jk], axis=1)
        dsa_s = dsa_select_attend(eq, jq, jw, pos_s, k_all, v_all, ik_all, kpos_s, topk_sample)
        mix_s = jnp.concatenate([fox_s, dsa_s], axis=-1) @ w_out[l]
        ys = post_sublayers(ys, mix_s, ln1_g[l], ln1_b[l], w_gate[l], w_up[l], w_down[l], ln2_g[l], ln2_b[l])
        for lst, arr in zip(s_st, (gk, gv, glf, ek, ev, jk)):
            lst.append(arr)
    p_fox_k, p_fox_v, p_fox_logf, p_dsa_k, p_dsa_v, p_idx_k = [jnp.stack(a, axis=0) for a in p_st]
    s_fox_k, s_fox_v, s_fox_logf, s_dsa_k, s_dsa_v, s_idx_k = [jnp.stack(a, axis=0) for a in s_st]
    return (yp, ys, p_fox_k, p_fox_v, p_fox_logf, p_dsa_k, p_dsa_v, p_idx_k,
            s_fox_k, s_fox_v, s_fox_logf, s_dsa_k, s_dsa_v, s_idx_k)
```

```cpp
#include <hip/hip_runtime.h>
#include <hip/hip_cooperative_groups.h>
#include <cstdio>
#include <cstdint>
namespace cg = cooperative_groups;

#define LAS __attribute__((address_space(3)))
typedef unsigned short bf16;
typedef short bf16x8 __attribute__((ext_vector_type(8)));
typedef float f32x4 __attribute__((ext_vector_type(4)));
typedef float f32x16 __attribute__((ext_vector_type(16)));
typedef unsigned u32x4 __attribute__((ext_vector_type(4)));
typedef unsigned u32x2 __attribute__((ext_vector_type(2)));
typedef short s16x4 __attribute__((ext_vector_type(4)));

constexpr int DM = 1024, SEQ = 4096, NBATCH = 16, MP = NBATCH * SEQ, DB = 8, DT = 32, MS = DB * DT, MT = MP + MS;
constexpr int KVS = 4160, NKEY_S = 4128;
constexpr int NIN = 2816, DFF = 2816, NGU = 5632;
constexpr int MW = 65;
constexpr int SCR_LD = 4160;
constexpr float ALPHA = 1.18920711500272f, LN_EPS = 1e-5f, LOG2E = 1.4426950408889634f, C2 = 0.125f * 1.4426950408889634f;

constexpr size_t O_YP = 0, O_YS = O_YP + (size_t)MP * DM, O_PFK = O_YS + (size_t)MS * DM, O_PFV = O_PFK + (size_t)MP * 512, O_PFLF = O_PFV + (size_t)MP * 512,
                 O_PDK = O_PFLF + (size_t)MP * 8, O_PDV = O_PDK + (size_t)MP * 128, O_PIK = O_PDV + (size_t)MP * 128, O_SFK = O_PIK + (size_t)MP * 64,
                 O_SFV = O_SFK + (size_t)MS * 512, O_SFLF = O_SFV + (size_t)MS * 512, O_SDK = O_SFLF + (size_t)MS * 8, O_SDV = O_SDK + (size_t)MS * 128,
                 O_SIK = O_SDV + (size_t)MS * 128, O_END = O_SIK + (size_t)MS * 64;
static_assert(O_END == 156321792, "d_out size");

constexpr size_t al256(size_t x) { return (x + 255) & ~(size_t)255; }
constexpr size_t WS_WIN = 0, WS_WO = WS_WIN + al256((size_t)NIN * DM * 2), WS_WGU = WS_WO + al256((size_t)DM * DM * 2), WS_WD = WS_WGU + al256((size_t)NGU * DM * 2),
                 WS_ROPE = WS_WD + al256((size_t)DM * DFF * 2), WS_XB = WS_ROPE + al256((size_t)NKEY_S * 16 * 4), WS_AO = WS_XB  ,
                 WS_FQ = WS_XB + al256((size_t)MT * DM * 2), WS_FKP = WS_FQ + al256((size_t)MT * 512 * 2), WS_FVP = WS_FKP + al256((size_t)MP * 512 * 2),
                 WS_FKA = WS_FVP + al256((size_t)MP * 512 * 2), WS_FVA = WS_FKA + al256((size_t)DB * KVS * 512 * 2), WS_DQ = WS_FVA + al256((size_t)DB * KVS * 512 * 2),
                 WS_DKP = WS_DQ + al256((size_t)MT * 512 * 2), WS_DVP = WS_DKP + al256((size_t)MP * 128 * 2), WS_DKA = WS_DVP + al256((size_t)MP * 128 * 2),
                 WS_DVA = WS_DKA + al256((size_t)DB * KVS * 128 * 2), WS_IQ = WS_DVA + al256((size_t)DB * KVS * 128 * 2), WS_IKP = WS_IQ + al256((size_t)MT * 256 * 2),
                 WS_IKA = WS_IKP + al256((size_t)MP * 64 * 2), WS_IW = WS_IKA + al256((size_t)DB * KVS * 64 * 2), WS_BIASP = WS_IW + al256((size_t)MT * 4 * 4),
                 WS_BIASS = WS_BIASP + al256((size_t)NBATCH * 8 * SEQ * 4), WS_NORM = WS_BIASS + al256((size_t)DB * 8 * KVS * 4), WS_SCR = WS_NORM + 4096  ,
                 WS_MASK = WS_SCR + al256((size_t)256 * 64 * SCR_LD * 4), WS_END1 = WS_MASK + al256((size_t)MT * MW * 8);
constexpr size_t WS_Z = WS_FQ, WS_HB = WS_Z + al256((size_t)MT * DM * 4), WS_ACT = WS_HB + al256((size_t)MT * DM * 2), WS_ST1 = WS_ACT + al256((size_t)MT * DFF * 2),
                 WS_ST2 = WS_ST1 + al256((size_t)MT * 16 * 8), WS_RS1 = WS_ST2 + al256((size_t)MT * 16 * 8), WS_END2 = WS_RS1 + al256((size_t)MT * 8);
constexpr size_t WS_Z2B = WS_XB;
constexpr size_t WS_NEED = WS_END1 > WS_END2 ? WS_END1 : WS_END2;
static_assert(WS_NEED <= (size_t)1073741824, "workspace map exceeds 4x the largest tensor");

struct KP {
    const float *xp, *xs, *cfk, *cfv, *cflf, *cdk, *cdv, *cik, *w_in, *b_forget, *w_out, *ln1g, *ln1b, *w_gate, *w_up, *w_down, *ln2g, *ln2b;
    float* out; unsigned char* ws;
};
namespace pg8 {
#define PG8_LAS __attribute__((address_space(3)))
typedef unsigned short bf16_t;
typedef short bf16x8 __attribute__((ext_vector_type(8)));
typedef float f32x4 __attribute__((ext_vector_type(4)));
typedef unsigned u32x4 __attribute__((ext_vector_type(4)));
constexpr int BM = 256, BK = 64, HALF = 128, HTB = HALF * BK * 2  , STAGE_BYTES = 8 * HTB, NXCD = 8, WGM = 8;

__host__ __device__ __forceinline__ int lds_byte(int r, int c) { const int st = (r >> 4) * 2 + (c >> 5), rr = r & 15, cc = c & 31, ob = rr * 64 + cc * 2; return st * 1024 + (ob ^ (((ob >> 9) & 1) << 5)); }
__host__ __device__ __forceinline__ void stage_rc(int b, int& R, int& C) { const int st = b / 1024, sb = b % 1024, swz = sb ^ (((sb >> 9) & 1) << 5); R = (st >> 1) * 16 + swz / 64; C = (st & 1) * 32 + (swz % 64) / 2; }
__host__ __device__ __forceinline__ int perm32(int rho) { const int n = rho >> 4, i = rho & 15; return 8 * (i >> 2) + 4 * n + (i & 3); }

struct Unit { int pm, pn; };
struct Gemm { const bf16_t* A; const bf16_t* Bt; int M, N, K; };

struct StaticOrder {
    int nM, nN, nwg, G, c;
    __host__ __device__ void init(int M, int N, int G_, int c_) { nM = M / BM; nN = N / BM; nwg = nM * nN; G = G_; c = c_; }
    __host__ __device__ bool next(int i, Unit& u) const {
        const long L = (long)i * G + c; if (L >= nwg) return false;
        int wgid = (int)L; { const int q = nwg / NXCD, r = nwg % NXCD, xcd = wgid % NXCD, off = wgid / NXCD; wgid = (xcd < r ? xcd * (q + 1) : r * (q + 1) + (xcd - r) * q) + off; }
        const int nig = WGM * nN, gid = wgid / nig, fm = gid * WGM, gsz = (nM - fm) < WGM ? (nM - fm) : WGM;
        u.pm = fm + ((wgid % nig) % gsz); u.pn = (wgid % nig) / gsz; return true;
    }
    __device__ __forceinline__ void a_ready(const Unit&) const {}
    __device__ __forceinline__ void done(const Unit&) const {}
};

__device__ __forceinline__ unsigned cvt_pk_bf16(float lo, float hi) { unsigned r; asm volatile("v_cvt_pk_bf16_f32 %0, %1, %2" : "=v"(r) : "v"(lo), "v"(hi)); return r; }
typedef float f32x2 __attribute__((ext_vector_type(2)));
__device__ __forceinline__ void st_bf16x8(bf16_t* p, f32x4 v0, f32x4 v1) { u32x4 w; w.x = cvt_pk_bf16(v0[0], v0[1]); w.y = cvt_pk_bf16(v0[2], v0[3]); w.z = cvt_pk_bf16(v1[0], v1[1]); w.w = cvt_pk_bf16(v1[2], v1[3]); *(u32x4*)p = w; }
__device__ __forceinline__ void st_f32x8(float* p, f32x4 v0, f32x4 v1) { *(f32x4*)p = v0; *(f32x4*)(p + 4) = v1; }
__device__ __forceinline__ void rope8(f32x4& v0, f32x4& v1, const float* tab, int fq) {
    f32x4 o0, o1; const bool oddrow = (fq & 1) != 0;
#pragma unroll
    for (int j = 0; j < 4; ++j) {
        { const unsigned u = __float_as_uint(v0[j]); auto rr = __builtin_amdgcn_permlane16_swap(u, u, false, false); o0[j] = __uint_as_float(oddrow ? rr[0] : rr[1]); }
        { const unsigned u = __float_as_uint(v1[j]); auto rr = __builtin_amdgcn_permlane16_swap(u, u, false, false); o1[j] = __uint_as_float(oddrow ? rr[0] : rr[1]); }
    }
    if (fq < 2) {
        const f32x4 c0 = *(const f32x4*)tab, c1 = *(const f32x4*)(tab + 4), s0 = *(const f32x4*)(tab + 8), s1 = *(const f32x4*)(tab + 12);
        if (fq == 0) { v0 = v0 * c0 - o0 * s0; v1 = v1 * c1 - o1 * s1; } else { v0 = v0 * c0 + o0 * s0; v1 = v1 * c1 + o1 * s1; }
    }
}
struct EpiIn {
    static constexpr bool PERM = true, AFTER_DRAIN = false;
    float* out; unsigned char* ws; const float* bforget;
    __device__ __forceinline__ void operator()(const f32x4 (&acc)[2][2][4][2], const Unit& u, int wr, int wc, int fr, int fq) const {
        const int pn = u.pn; const bool samp = (u.pm == MP / 256);
        const float* rope = (const float*)(ws + WS_ROPE);
#pragma unroll
        for (int ai = 0; ai < 2; ++ai)
#pragma unroll
            for (int m = 0; m < 4; ++m) {
                const int row = u.pm * 256 + ai * 128 + wr * 64 + m * 16 + fr;
                const int r2 = row - MP, sb = r2 >> 5, ss = r2 & 31;
                const int pos = samp ? (4096 + ss) : (row & 4095);
                const size_t arow = samp ? ((size_t)sb * KVS + 4096 + ss) : (size_t)row;
                const float* tab = rope + pos * 16;
#pragma unroll
                for (int bj = 0; bj < 2; ++bj) {
                    f32x4 v0 = acc[ai][bj][m][0], v1 = acc[ai][bj][m][1];
                    const int cit = bj * 128 + wc * 32 + fq * 8;
                    if (pn < 2) { st_bf16x8((bf16_t*)(ws + WS_FQ) + (size_t)row * 512 + pn * 256 + cit, v0 * C2, v1 * C2); }
                    else if (pn < 6) {
                        const bool isv = pn >= 4; const int col = (pn & 1) * 256 + cit;
                        float* fo = samp ? out + (isv ? O_SFV : O_SFK) + (size_t)r2 * 512 : out + (isv ? O_PFV : O_PFK) + (size_t)row * 512;
                        bf16_t* bo = (bf16_t*)(ws + (samp ? (isv ? WS_FVA : WS_FKA) : (isv ? WS_FVP : WS_FKP))) + arow * 512;
                        st_f32x8(fo + col, v0, v1); st_bf16x8(bo + col, v0, v1);
                    } else if (pn < 8) {
                        if ((wc & 1) == 0) rope8(v0, v1, tab, fq);
                        st_bf16x8((bf16_t*)(ws + WS_DQ) + (size_t)row * 512 + (pn - 6) * 256 + cit, v0 * C2, v1 * C2);
                    } else if (pn == 8) {
                        const bool isv = (bj == 1); const int col = cit - bj * 128;
                        if (!isv) { if ((wc & 1) == 0) rope8(v0, v1, tab, fq); }
                        float* fo = samp ? out + (isv ? O_SDV : O_SDK) + (size_t)r2 * 128 : out + (isv ? O_PDV : O_PDK) + (size_t)row * 128;
                        bf16_t* bo = (bf16_t*)(ws + (samp ? (isv ? WS_DVA : WS_DKA) : (isv ? WS_DVP : WS_DKP))) + arow * 128;
                        st_f32x8(fo + col, v0, v1); st_bf16x8(bo + col, v0, v1);
                    } else if (pn == 9) {
                        if ((wc & 1) == 0) rope8(v0, v1, tab, fq);
                        st_bf16x8((bf16_t*)(ws + WS_IQ) + (size_t)row * 256 + cit, v0, v1);
                    } else if (bj == 0) {
                        if (wc < 2) {
                            if (wc == 0) rope8(v0, v1, tab, fq);
                            float* fo = samp ? out + O_SIK + (size_t)r2 * 64 : out + O_PIK + (size_t)row * 64;
                            bf16_t* bo = (bf16_t*)(ws + (samp ? WS_IKA : WS_IKP)) + arow * 64;
                            st_f32x8(fo + cit, v0, v1); st_bf16x8(bo + cit, v0, v1);
                        } else if (wc == 2) {
                            if (fq == 0) {
                                const f32x4 b0 = *(const f32x4*)bforget, b1 = *(const f32x4*)(bforget + 4);
                                f32x4 z0 = v0 + b0, z1 = v1 + b1, l0, l1;
#pragma unroll
                                for (int j = 0; j < 4; ++j) { l0[j] = fminf(z0[j], 0.f) - log1pf(__expf(-fabsf(z0[j]))); l1[j] = fminf(z1[j], 0.f) - log1pf(__expf(-fabsf(z1[j]))); }
                                float* fo = samp ? out + O_SFLF + (size_t)r2 * 8 : out + O_PFLF + (size_t)row * 8;
                                st_f32x8(fo, l0, l1);
                            } else if (fq == 1) { *(f32x4*)((float*)(ws + WS_IW) + (size_t)row * 4) = v0; }
                        }
                    }
                }
            }
    }
};
__device__ __forceinline__ float add_xor16(float x) { const unsigned u = __builtin_bit_cast(unsigned, x); auto rr = __builtin_amdgcn_permlane16_swap(u, u, false, false); return __builtin_bit_cast(float, (unsigned)rr[0]) + __builtin_bit_cast(float, (unsigned)rr[1]); }
__device__ __forceinline__ float add_xor32(float x) { const unsigned u = __builtin_bit_cast(unsigned, x); auto rr = __builtin_amdgcn_permlane32_swap(u, u, false, false); return __builtin_bit_cast(float, (unsigned)rr[0]) + __builtin_bit_cast(float, (unsigned)rr[1]); }
struct EpiZ {
    static constexpr bool PERM = true, AFTER_DRAIN = false;
    const float* base_p; const float* base_s; float* zout; float* stats;
    __device__ __forceinline__ void operator()(const f32x4 (&acc)[2][2][4][2], const Unit& u, int wr, int wc, int fr, int fq) const {
        const bool samp = (u.pm == MP / 256);
#pragma unroll
        for (int ai = 0; ai < 2; ++ai)
#pragma unroll
            for (int m = 0; m < 4; ++m) {
                const int row = u.pm * 256 + ai * 128 + wr * 64 + m * 16 + fr;
                const float* bp = samp ? base_s + (size_t)(row - MP) * DM : base_p + (size_t)row * DM;
                float sm = 0.f, sq = 0.f;
#pragma unroll
                for (int bj = 0; bj < 2; ++bj) {
                    const int col = u.pn * 256 + bj * 128 + wc * 32 + fq * 8;
                    const f32x4 x0 = *(const f32x4*)(bp + col), x1 = *(const f32x4*)(bp + col + 4);
                    const f32x4 z0 = x0 * ALPHA + acc[ai][bj][m][0], z1 = x1 * ALPHA + acc[ai][bj][m][1];
                    st_f32x8(zout + (size_t)row * DM + col, z0, z1);
                    sm += (z0[0] + z0[1]) + (z0[2] + z0[3]) + (z1[0] + z1[1]) + (z1[2] + z1[3]);
                    sq += (z0[0] * z0[0] + z0[1] * z0[1]) + (z0[2] * z0[2] + z0[3] * z0[3]) + (z1[0] * z1[0] + z1[1] * z1[1]) + (z1[2] * z1[2] + z1[3] * z1[3]);
                }
                sm = add_xor32(add_xor16(sm)); sq = add_xor32(add_xor16(sq));
                if (fq == 0) { float* sp = stats + ((size_t)row * 16 + u.pn * 4 + wc) * 2; sp[0] = sm; sp[1] = sq; }
            }
    }
};
struct EpiZ2 {
    static constexpr bool PERM = true, AFTER_DRAIN = false;
    const float* z; const float* rowstat; const float* g1; const float* b1; bf16_t* z2b; float* stats;
    __device__ __forceinline__ void operator()(const f32x4 (&acc)[2][2][4][2], const Unit& u, int wr, int wc, int fr, int fq) const {
#pragma unroll
        for (int ai = 0; ai < 2; ++ai)
#pragma unroll
            for (int m = 0; m < 4; ++m) {
                const int row = u.pm * 256 + ai * 128 + wr * 64 + m * 16 + fr;
                const float mean = rowstat[2 * (size_t)row], rstd = rowstat[2 * (size_t)row + 1];
                float sm = 0.f, sq = 0.f;
#pragma unroll
                for (int bj = 0; bj < 2; ++bj) {
                    const int col = u.pn * 256 + bj * 128 + wc * 32 + fq * 8;
                    const float* zp = z + (size_t)row * DM + col;
                    const f32x4 x0 = *(const f32x4*)zp, x1 = *(const f32x4*)(zp + 4);
                    const f32x4 ga = *(const f32x4*)(g1 + col), gb = *(const f32x4*)(g1 + col + 4), ba = *(const f32x4*)(b1 + col), bb = *(const f32x4*)(b1 + col + 4);
                    const f32x4 h0 = (x0 - mean) * rstd * ga + ba, h1 = (x1 - mean) * rstd * gb + bb;
                    const f32x4 z0 = h0 * ALPHA + acc[ai][bj][m][0], z1 = h1 * ALPHA + acc[ai][bj][m][1];
                    st_bf16x8(z2b + (size_t)row * DM + col, z0, z1);
                    sm += (z0[0] + z0[1]) + (z0[2] + z0[3]) + (z1[0] + z1[1]) + (z1[2] + z1[3]);
                    sq += (z0[0] * z0[0] + z0[1] * z0[1]) + (z0[2] * z0[2] + z0[3] * z0[3]) + (z1[0] * z1[0] + z1[1] * z1[1]) + (z1[2] * z1[2] + z1[3] * z1[3]);
                }
                sm = add_xor32(add_xor16(sm)); sq = add_xor32(add_xor16(sq));
                if (fq == 0) { float* sp = stats + ((size_t)row * 16 + u.pn * 4 + wc) * 2; sp[0] = sm; sp[1] = sq; }
            }
    }
};
struct EpiAct {
    static constexpr bool PERM = true, AFTER_DRAIN = false;
    bf16_t* act;
    __device__ __forceinline__ void operator()(const f32x4 (&acc)[2][2][4][2], const Unit& u, int wr, int wc, int fr, int fq) const {
#pragma unroll
        for (int ai = 0; ai < 2; ++ai)
#pragma unroll
            for (int m = 0; m < 4; ++m) {
                const int row = u.pm * 256 + ai * 128 + wr * 64 + m * 16 + fr;
                f32x4 a0, a1;
#pragma unroll
                for (int j = 0; j < 4; ++j) {
                    const float g0 = acc[ai][0][m][0][j], g1 = acc[ai][0][m][1][j];
                    a0[j] = g0 * __builtin_amdgcn_rcpf(1.f + __expf(-g0)) * acc[ai][1][m][0][j];
                    a1[j] = g1 * __builtin_amdgcn_rcpf(1.f + __expf(-g1)) * acc[ai][1][m][1][j];
                }
                st_bf16x8(act + (size_t)row * DFF + u.pn * 128 + wc * 32 + fq * 8, a0, a1);
            }
    }
};
template <class Epi, class Sched, bool ALIGN_EPI = false, bool SP2 = false>
__device__ __forceinline__ void gemm_phase(PG8_LAS unsigned char* lds, const Gemm g, const Sched& S, const Epi& E) {
    int tid_ = threadIdx.x; asm volatile("" : "+v"(tid_));
    const int tid = tid_, wid = __builtin_amdgcn_readfirstlane(tid >> 6), lane = tid & 63, wr = wid >> 2, wc = wid & 3, fr = lane & 15, fq = lane >> 4;
    const int K = g.K, nt = K / BK;
    unsigned voffA[2], voffB[2];
#pragma unroll
    for (int i = 0; i < 2; ++i) { int R, C; stage_rc(tid * 16 + i * 8192, R, C); const int Rb = Epi::PERM ? ((R & ~31) + perm32(R & 31)) : R;
        voffA[i] = (unsigned)(R * K + C) * 2u; voffB[i] = (unsigned)(Rb * K + C) * 2u; }
    const size_t kstep = (size_t)(BK * 2);
    const size_t hstep = (size_t)HALF * K * 2;
    const size_t tstep = 2 * hstep;
    const unsigned ldsw = (unsigned)wid * 1024u;
    const int aoff = lds_byte(wr * 64 + fr, fq * 8), boff = lds_byte(wc * 32 + fr, fq * 8);
#define PG8_SA(b, h) (((b) * 2 + (h)) * HTB)
#define PG8_SB(b, h) ((4 + (b) * 2 + (h)) * HTB)
#define PG8_STAGE(bufoff, gbase, voff) do { _Pragma("unroll") for (int _i = 0; _i < 2; ++_i) \
        __builtin_amdgcn_global_load_lds((const unsigned*)((const char*)(gbase) + (voff)[_i]), (PG8_LAS unsigned*)(lds + (bufoff) + ldsw + _i * 8192), 16, 0, 0); } while (0)
#define PG8_LDA(dst, b, h) do { _Pragma("unroll") for (int m = 0; m < 4; ++m) _Pragma("unroll") for (int k = 0; k < 2; ++k) dst[m][k] = *(const PG8_LAS bf16x8*)(lds + PG8_SA(b, h) + aoff + m * 2048 + k * 1024); } while (0)
#define PG8_LDB(dst, b, h) do { _Pragma("unroll") for (int n = 0; n < 2; ++n) _Pragma("unroll") for (int k = 0; k < 2; ++k) dst[n][k] = *(const PG8_LAS bf16x8*)(lds + PG8_SB(b, h) + boff + n * 2048 + k * 1024); } while (0)
#define PG8_MMA(ai, bj, At, Bt) do { __builtin_amdgcn_s_setprio(1); _Pragma("unroll") for (int m = 0; m < 4; ++m) _Pragma("unroll") for (int n = 0; n < 2; ++n) _Pragma("unroll") for (int k = 0; k < 2; ++k) \
        acc[ai][bj][m][n] = __builtin_amdgcn_mfma_f32_16x16x32_bf16(Bt[n][k], At[m][k], acc[ai][bj][m][n], 0, 0, 0); __builtin_amdgcn_s_setprio(0); } while (0)
#define PG8_WAIT_V(n) asm volatile("s_waitcnt vmcnt(" #n ")" ::: "memory")
#define PG8_WAIT_L(n) asm volatile("s_waitcnt lgkmcnt(" #n ")" ::: "memory")
#define PG8_BAR __builtin_amdgcn_s_barrier()
#define PG8_SCHED __builtin_amdgcn_sched_barrier(0)
    Unit cur, nxt; int ui = 0;
    if (!S.next(0, cur)) return;
    f32x4 acc[2][2][4][2];
#pragma unroll
    for (int a = 0; a < 2; ++a)
#pragma unroll
        for (int b = 0; b < 2; ++b)
#pragma unroll
            for (int m = 0; m < 4; ++m)
#pragma unroll
                for (int n = 0; n < 2; ++n) acc[a][b][m][n] = (f32x4){0.f, 0.f, 0.f, 0.f};
    bf16x8 At[4][2], B0[2][2], B1[2][2];
    const char* cA = (const char*)g.A + (size_t)cur.pm * tstep; const char* cB = (const char*)g.Bt + (size_t)cur.pn * tstep;
    S.a_ready(cur);
    if constexpr (SP2) {
        PG8_STAGE(PG8_SB(0, 0), cB, voffB); PG8_STAGE(PG8_SB(0, 1), cB + hstep, voffB); PG8_STAGE(PG8_SA(0, 0), cA, voffA); PG8_STAGE(PG8_SA(0, 1), cA + hstep, voffA);
        if (wr == 1) PG8_BAR;
        PG8_WAIT_V(2); PG8_BAR;
        PG8_STAGE(PG8_SB(1, 0), cB + kstep, voffB); PG8_STAGE(PG8_SA(1, 0), cA + kstep, voffA); PG8_STAGE(PG8_SB(1, 1), cB + hstep + kstep, voffB);
        PG8_WAIT_V(6); PG8_BAR;
    } else {
        PG8_STAGE(PG8_SB(0, 0), cB, voffB); PG8_STAGE(PG8_SA(0, 0), cA, voffA); PG8_STAGE(PG8_SB(0, 1), cB + hstep, voffB); PG8_STAGE(PG8_SA(0, 1), cA + hstep, voffA);
        if (wr == 1) PG8_BAR;
        PG8_WAIT_V(4); PG8_BAR;
        PG8_STAGE(PG8_SB(1, 0), cB + kstep, voffB); PG8_STAGE(PG8_SA(1, 0), cA + kstep, voffA); PG8_STAGE(PG8_SB(1, 1), cB + hstep + kstep, voffB);
        PG8_WAIT_V(6); PG8_BAR;
    }
    for (;;) {
        const bool has_next = S.next(ui + 1, nxt);
        const char* nA = has_next ? (const char*)g.A + (size_t)nxt.pm * tstep : cA; const char* nB = has_next ? (const char*)g.Bt + (size_t)nxt.pn * tstep : cB;
        for (int t = 0; t < nt; t += 2) {
            const bool last = (t == nt - 2);
            const char* a1 = cA + (size_t)(t + 1) * kstep;
            const char* a2 = last ? nA : cA + (size_t)(t + 2) * kstep; const char* b2 = last ? nB : cB + (size_t)(t + 2) * kstep;
            const char* a3 = a2 + kstep; const char* b3 = b2 + kstep;
            if (last && has_next) S.a_ready(nxt);
            if constexpr (SP2) {
            PG8_LDB(B0, 0, 0); PG8_LDB(B1, 0, 1); PG8_SCHED; PG8_LDA(At, 0, 0); PG8_STAGE(PG8_SA(1, 1), a1 + hstep, voffA);
            PG8_WAIT_V(8); PG8_WAIT_L(0); PG8_BAR; PG8_MMA(0, 0, At, B0); PG8_MMA(0, 1, At, B1); PG8_BAR; PG8_SCHED;
            PG8_LDA(At, 0, 1); PG8_STAGE(PG8_SB(0, 0), b2, voffB); PG8_STAGE(PG8_SB(0, 1), b2 + hstep, voffB); PG8_STAGE(PG8_SA(0, 0), a2, voffA);
            PG8_WAIT_V(8); PG8_WAIT_L(0); PG8_BAR; PG8_MMA(1, 0, At, B0); PG8_MMA(1, 1, At, B1); PG8_BAR; PG8_SCHED;
            PG8_LDB(B0, 1, 0); PG8_LDB(B1, 1, 1); PG8_SCHED; PG8_LDA(At, 1, 0); PG8_STAGE(PG8_SA(0, 1), a2 + hstep, voffA);
            PG8_WAIT_V(8); PG8_WAIT_L(0); PG8_BAR; PG8_MMA(0, 0, At, B0); PG8_MMA(0, 1, At, B1); PG8_BAR; PG8_SCHED;
            PG8_LDA(At, 1, 1); PG8_STAGE(PG8_SB(1, 0), b3, voffB); PG8_STAGE(PG8_SB(1, 1), b3 + hstep, voffB); PG8_STAGE(PG8_SA(1, 0), a3, voffA);
            PG8_WAIT_V(8); PG8_WAIT_L(0); PG8_BAR; PG8_MMA(1, 0, At, B0); PG8_MMA(1, 1, At, B1); PG8_BAR; PG8_SCHED;
            } else {
            PG8_LDB(B0, 0, 0); PG8_SCHED; PG8_LDA(At, 0, 0); PG8_STAGE(PG8_SA(1, 1), a1 + hstep, voffA);
            PG8_WAIT_L(8); PG8_BAR; PG8_WAIT_L(0); PG8_MMA(0, 0, At, B0); PG8_BAR; PG8_SCHED;
            PG8_LDB(B1, 0, 1); PG8_STAGE(PG8_SB(0, 0), b2, voffB);
            PG8_BAR; PG8_WAIT_L(0); PG8_MMA(0, 1, At, B1); PG8_BAR;
            PG8_LDA(At, 0, 1); PG8_STAGE(PG8_SA(0, 0), a2, voffA);
            PG8_BAR; PG8_WAIT_L(0); PG8_MMA(1, 0, At, B0); PG8_BAR; PG8_SCHED;
            PG8_STAGE(PG8_SB(0, 1), b2 + hstep, voffB);
            PG8_WAIT_V(6); PG8_BAR; PG8_MMA(1, 1, At, B1); PG8_BAR;
            PG8_LDB(B0, 1, 0); PG8_SCHED; PG8_LDA(At, 1, 0); PG8_STAGE(PG8_SA(0, 1), a2 + hstep, voffA);
            PG8_WAIT_L(8); PG8_BAR; PG8_WAIT_L(0); PG8_MMA(0, 0, At, B0); PG8_BAR; PG8_SCHED;
            PG8_LDB(B1, 1, 1); PG8_STAGE(PG8_SB(1, 0), b3, voffB);
            PG8_BAR; PG8_WAIT_L(0); PG8_MMA(0, 1, At, B1); PG8_BAR;
            PG8_LDA(At, 1, 1); PG8_STAGE(PG8_SA(1, 0), a3, voffA);
            PG8_BAR; PG8_WAIT_L(0); PG8_MMA(1, 0, At, B0); PG8_BAR; PG8_SCHED;
            PG8_STAGE(PG8_SB(1, 1), b3 + hstep, voffB);
            PG8_WAIT_V(6); PG8_BAR; PG8_MMA(1, 1, At, B1); PG8_BAR;
            }
        }
        if constexpr (ALIGN_EPI) { if (wr == 0) PG8_BAR; }
        if constexpr (!Epi::AFTER_DRAIN) { E(acc, cur, wr, wc, fr, fq); S.done(cur); }
        if (!has_next) break;
#pragma unroll
        for (int a = 0; a < 2; ++a)
#pragma unroll
            for (int b = 0; b < 2; ++b)
#pragma unroll
                for (int m = 0; m < 4; ++m)
#pragma unroll
                    for (int n = 0; n < 2; ++n) acc[a][b][m][n] = (f32x4){0.f, 0.f, 0.f, 0.f};
        cur = nxt; cA = nA; cB = nB; ++ui;
        if constexpr (ALIGN_EPI) { if (wr == 1) PG8_BAR; }
    }
    PG8_WAIT_V(0);
    if constexpr (!ALIGN_EPI) { if (wr == 0) PG8_BAR; }
    PG8_BAR;
    if constexpr (Epi::AFTER_DRAIN) { E.fused(acc, cur, wr, wc, fr, fq, lds, wid, lane); S.done(cur); }
#undef PG8_SA
#undef PG8_SB
#undef PG8_STAGE
#undef PG8_LDA
#undef PG8_LDB
#undef PG8_MMA
#undef PG8_WAIT_V
#undef PG8_WAIT_L
#undef PG8_BAR
#undef PG8_SCHED
}
}
#ifndef REP_SEL
#define REP_SEL 1
#endif
#define LDS_WAIT() asm volatile("s_waitcnt lgkmcnt(0)" ::: "memory")
__device__ __forceinline__ unsigned pk2(float lo, float hi) { return pg8::cvt_pk_bf16(lo, hi); }
__device__ __forceinline__ float wave_sum(float v) {
#pragma unroll
    for (int o = 1; o < 64; o <<= 1) v += __shfl_xor(v, o);
    return v;
}
template <int CTRL> __device__ __forceinline__ int dpp_mov(int x) { return __builtin_amdgcn_update_dpp(x, x, CTRL, 0xF, 0xF, false); }
__device__ __forceinline__ float row_sum16(float x) {
    x += __int_as_float(dpp_mov<0xB1>(__float_as_int(x))); x += __int_as_float(dpp_mov<0x4E>(__float_as_int(x)));
    x += __int_as_float(dpp_mov<0x124>(__float_as_int(x))); x += __int_as_float(dpp_mov<0x128>(__float_as_int(x))); return x;
}
__device__ __forceinline__ unsigned row_max16(unsigned x) {
    unsigned y;
    y = (unsigned)dpp_mov<0xB1>((int)x); x = x > y ? x : y; y = (unsigned)dpp_mov<0x4E>((int)x); x = x > y ? x : y;
    y = (unsigned)dpp_mov<0x124>((int)x); x = x > y ? x : y; y = (unsigned)dpp_mov<0x128>((int)x); x = x > y ? x : y; return x;
}
struct Ctx { int tid, lane, wid, gw, ngw; LAS unsigned char* lds; };

__device__ __forceinline__ void transpose_item(const float* colp, int ldw, int k0, bf16* WT, int K, int dst_row0, LAS float* scr, int lane) {
#pragma unroll 8
    for (int i = 0; i < 32; ++i) { const int kk = 2 * i + (lane >> 5); scr[kk * 33 + (lane & 31)] = colp ? colp[(size_t)(k0 + kk) * ldw] : 0.f; }
    LDS_WAIT(); asm volatile("" ::: "memory");
    const int c = lane & 7;
#pragma unroll
    for (int j = 0; j < 4; ++j) { const int n = (lane >> 3) + 8 * j; const LAS float* s = scr + (8 * c) * 33 + n;
        u32x4 o; o.x = pk2(s[0 * 33], s[1 * 33]); o.y = pk2(s[2 * 33], s[3 * 33]); o.z = pk2(s[4 * 33], s[5 * 33]); o.w = pk2(s[6 * 33], s[7 * 33]);
        *(u32x4*)(WT + (size_t)(dst_row0 + n) * K + k0 + 8 * c) = o; }
    LDS_WAIT(); asm volatile("" ::: "memory");
}
__device__ __forceinline__ int win_src_col(int d) {
    if (d < 1536) return d;
    if (d < 2624) return d + 8;
    if (d < 2632) return 1536 + (d - 2624);
    if (d < 2636) return d;
    return -1;
}
__device__ __forceinline__ void cvt_copy(const Ctx& c, const float* src, bf16* dst, size_t n) {
    const size_t stride = (size_t)c.ngw * 64 * 8;
    for (size_t i = ((size_t)c.gw * 64 + c.lane) * 8; i < n; i += 4 * stride) {
        f32x4 a[4], b[4];
#pragma unroll
        for (int u = 0; u < 4; ++u) { const size_t j = i + u * stride; const size_t jc = j < n ? j : i; a[u] = *(const f32x4*)(src + jc); b[u] = *(const f32x4*)(src + jc + 4); }
#pragma unroll
        for (int u = 0; u < 4; ++u) { const size_t j = i + u * stride; if (j < n) {
            u32x4 o; o.x = pk2(a[u][0], a[u][1]); o.y = pk2(a[u][2], a[u][3]); o.z = pk2(b[u][0], b[u][1]); o.w = pk2(b[u][2], b[u][3]);
            *(u32x4*)(dst + j) = o; } }
    }
}
__device__ __forceinline__ void p0_prologue(const KP& p, const Ctx& c) {
    LAS float* scr = (LAS float*)(c.lds + c.wid * 16384);
    unsigned char* ws = p.ws;
    constexpr int I_IN = (NIN / 32) * 16, I_O = 32 * 16, I_GU = (NGU / 32) * 16, I_D = 32 * (DFF / 64);
    for (int it = c.gw; it < I_IN + I_O + I_GU + I_D; it += c.ngw) {
        int r = it; const int ln = c.lane & 31;
        if (r < I_IN) { const int nb = r >> 4, kb = r & 15; const int sc = win_src_col(32 * nb + ln);
            transpose_item(sc >= 0 ? p.w_in + sc : nullptr, 2636, 64 * kb, (bf16*)(ws + WS_WIN), DM, 32 * nb, scr, c.lane); continue; } r -= I_IN;
        if (r < I_O) { const int nb = r >> 4, kb = r & 15; transpose_item(p.w_out + 32 * nb + ln, DM, 64 * kb, (bf16*)(ws + WS_WO), DM, 32 * nb, scr, c.lane); continue; } r -= I_O;
        if (r < I_GU) { const int nb = r >> 4, kb = r & 15; const int d = 32 * nb + ln, pn = d >> 8, rr = d & 255;
            transpose_item(rr < 128 ? p.w_gate + 128 * pn + rr : p.w_up + 128 * pn + rr - 128, DFF, 64 * kb, (bf16*)(ws + WS_WGU), DM, 32 * nb, scr, c.lane); continue; } r -= I_GU;
        { const int nb = r / (DFF / 64), kb = r % (DFF / 64); transpose_item(p.w_down + 32 * nb + ln, DM, 64 * kb, (bf16*)(ws + WS_WD), DFF, 32 * nb, scr, c.lane); }
    }
    cvt_copy(c, p.xp, (bf16*)(ws + WS_XB), (size_t)MP * DM);
    cvt_copy(c, p.xs, (bf16*)(ws + WS_XB) + (size_t)MP * DM, (size_t)MS * DM);
    for (int b = 0; b < DB; ++b) {
        cvt_copy(c, p.cik + (size_t)b * 4096 * 64, (bf16*)(ws + WS_IKA) + (size_t)b * KVS * 64, (size_t)4096 * 64);
    }
    for (int g = c.gw * 64 + c.lane; g < DB * 32 * 160; g += c.ngw * 64) {
        const int b = g / (32 * 160), rr = (g / 160) & 31, pc = g % 160; const size_t rowi = (size_t)b * KVS + NKEY_S + rr; const u32x4 z = (u32x4){0u, 0u, 0u, 0u};
        if (pc < 64) *(u32x4*)((bf16*)(ws + WS_FKA) + rowi * 512 + pc * 8) = z;
        else if (pc < 128) *(u32x4*)((bf16*)(ws + WS_FVA) + rowi * 512 + (pc - 64) * 8) = z;
        else if (pc < 144) *(u32x4*)((bf16*)(ws + WS_DKA) + rowi * 128 + (pc - 128) * 8) = z;
        else *(u32x4*)((bf16*)(ws + WS_DVA) + rowi * 128 + (pc - 144) * 8) = z;
    }
    if (c.gw == 0) { for (int i = c.lane; i < 1024; i += 64) ((unsigned*)(ws + WS_NORM))[i] = 0u; }
    for (int g = c.gw * 64 + c.lane; g < NKEY_S * 8; g += c.ngw * 64) {
        const int pos = g >> 3, i = g & 7;
        const float invf = i == 0 ? 1.0f : i == 1 ? 0.1939227432012558f : i == 2 ? 0.03760603070259094f : i == 3 ? 0.007292664609849453f : i == 4 ? 0.0014142135623842478f
                         : i == 5 ? 0.00027424818836152554f : i == 6 ? 5.318296098266728e-05f : 1.0313386155758053e-05f;
        const float ang = (float)pos * invf;
        double t = (double)ang * 0.15915494309189535; t -= rint(t);
        const double q = rint(t * 4.0); const double r = (t - q * 0.25) * 6.283185307179586; const int qi = ((int)q) & 3;
        const double r2 = r * r;
        const double sn = r * (1.0 + r2 * (-1.0 / 6 + r2 * (1.0 / 120 + r2 * (-1.0 / 5040 + r2 * (1.0 / 362880 + r2 * (-1.0 / 39916800 + r2 * (1.0 / 6227020800.0)))))));
        const double cs = 1.0 + r2 * (-0.5 + r2 * (1.0 / 24 + r2 * (-1.0 / 720 + r2 * (1.0 / 40320 + r2 * (-1.0 / 3628800 + r2 * (1.0 / 479001600.0 + r2 * (-1.0 / 87178291200.0)))))));
        const double cc = qi == 0 ? cs : qi == 1 ? -sn : qi == 2 ? -cs : sn;
        const double ssn = qi == 0 ? sn : qi == 1 ? cs : qi == 2 ? -sn : -cs;
        float* tab = (float*)(ws + WS_ROPE) + pos * 16;
        tab[i] = (float)cc; tab[8 + i] = (float)ssn;
    }
}

__device__ __forceinline__ void cumsum_item(const KP& p, int item, int lane) {
    const bool samp = item >= 16; const int b = samp ? item - 16 : item; const int n = samp ? NKEY_S : SEQ;
    const float* src0 = samp ? p.cflf + (size_t)b * 4096 * 8 : p.out + O_PFLF + (size_t)b * 4096 * 8;
    const float* src1 = p.out + O_SFLF + (size_t)b * 32 * 8;
    float* dst = samp ? (float*)(p.ws + WS_BIASS) + (size_t)b * 8 * KVS : (float*)(p.ws + WS_BIASP) + (size_t)b * 8 * SEQ;
    const int ds = samp ? KVS : SEQ;
    float acc[8];
#pragma unroll
    for (int h = 0; h < 8; ++h) acc[h] = 0.f;
#pragma unroll 1
    for (int i0 = 0; i0 < 65; i0 += 13) {
        f32x4 a[13], bb[13];
#pragma unroll
        for (int i = 0; i < 13; ++i) { const int s0 = lane * 65 + i0 + i, s = s0 < n ? s0 : n - 1; const float* r = s < 4096 ? src0 + (size_t)s * 8 : src1 + (size_t)(s - 4096) * 8; a[i] = *(const f32x4*)r; bb[i] = *(const f32x4*)(r + 4); }
#pragma unroll
        for (int i = 0; i < 13; ++i) { const bool ok = lane * 65 + i0 + i < n;
#pragma unroll
            for (int h = 0; h < 4; ++h) { acc[h] += ok ? a[i][h] : 0.f; acc[4 + h] += ok ? bb[i][h] : 0.f; } }
    }
    float run[8];
#pragma unroll
    for (int h = 0; h < 8; ++h) { float v = acc[h];
#pragma unroll
        for (int o = 1; o < 64; o <<= 1) { const float t = __shfl_up(v, o); if (lane >= o) v += t; }
        run[h] = v - acc[h]; }
#pragma unroll 1
    for (int i0 = 0; i0 < 65; i0 += 13) {
        f32x4 a[13], bb[13];
#pragma unroll
        for (int i = 0; i < 13; ++i) { const int s0 = lane * 65 + i0 + i, s = s0 < n ? s0 : n - 1; const float* r = s < 4096 ? src0 + (size_t)s * 8 : src1 + (size_t)(s - 4096) * 8; a[i] = *(const f32x4*)r; bb[i] = *(const f32x4*)(r + 4); }
#pragma unroll
        for (int i = 0; i < 13; ++i) { const int s = lane * 65 + i0 + i; if (s < n) {
#pragma unroll
            for (int h = 0; h < 4; ++h) { run[h] += a[i][h]; run[4 + h] += bb[i][h]; dst[(size_t)h * ds + s] = -run[h] * LOG2E; dst[(size_t)(4 + h) * ds + s] = -run[4 + h] * LOG2E; } } }
    }
}

__device__ __forceinline__ void norm_rows(const bf16* base, int r0, int nrows, int h, unsigned* dst, int lane) {
    float mx = 0.f;
    const bf16* bp = base + (size_t)(r0 + (lane >> 3)) * 512 + h * 64 + (lane & 7) * 8;
    const int nit = (nrows + 7) >> 3;
    for (int it0 = 0; it0 < nit; it0 += 8) {
        u32x4 w[8];
#pragma unroll
        for (int k = 0; k < 8; ++k) { int it = it0 + k; const int rr = 8 * it + (lane >> 3); const int itc = (rr < nrows) ? it : 0; w[k] = *(const u32x4*)(bp + (size_t)itc * 8 * 512); }
#pragma unroll
        for (int k = 0; k < 8; ++k) {
            float ss = 0.f;
#pragma unroll
            for (int j = 0; j < 4; ++j) { const float lo = __uint_as_float(w[k][j] << 16), hi2 = __uint_as_float(w[k][j] & 0xFFFF0000u); ss += lo * lo + hi2 * hi2; }
            ss += __int_as_float(dpp_mov<0xB1>(__float_as_int(ss))); ss += __int_as_float(dpp_mov<0x4E>(__float_as_int(ss))); ss += __int_as_float(dpp_mov<0x124>(__float_as_int(ss)));
            mx = fmaxf(mx, (lane & 4) ? 0.f : ss);
        }
    }
    unsigned mu = row_max16(__float_as_uint(mx));
    { auto rr = __builtin_amdgcn_permlane16_swap(mu, mu, false, false); mu = rr[0] > rr[1] ? rr[0] : rr[1]; }
    { auto rr = __builtin_amdgcn_permlane32_swap(mu, mu, false, false); mu = rr[0] > rr[1] ? rr[0] : rr[1]; }
    if (lane == 0) atomicMax(dst, mu);
}
__device__ __forceinline__ void norm_rows_f32(const float* base, int r0, int nrows, int h, unsigned* dst, int lane) {
    float mx = 0.f;
    const float* bp = base + (size_t)(r0 + (lane >> 4)) * 512 + h * 64 + (lane & 15) * 4;
    const int nit = (nrows + 3) >> 2;
    for (int it0 = 0; it0 < nit; it0 += 8) {
        f32x4 w[8];
#pragma unroll
        for (int k = 0; k < 8; ++k) { const int it = it0 + k; const int rr = 4 * it + (lane >> 4); const int itc = (rr < nrows) ? it : 0; w[k] = *(const f32x4*)(bp + (size_t)itc * 4 * 512); }
#pragma unroll
        for (int k = 0; k < 8; ++k) { float ss = (w[k][0] * w[k][0] + w[k][1] * w[k][1]) + (w[k][2] * w[k][2] + w[k][3] * w[k][3]);
            ss = row_sum16(ss); mx = fmaxf(mx, ss); }
    }
    unsigned mu = __float_as_uint(mx);
    { auto rr = __builtin_amdgcn_permlane16_swap(mu, mu, false, false); mu = rr[0] > rr[1] ? rr[0] : rr[1]; }
    { auto rr = __builtin_amdgcn_permlane32_swap(mu, mu, false, false); mu = rr[0] > rr[1] ? rr[0] : rr[1]; }
    if (lane == 0) atomicMax(dst, mu);
}
__device__ __forceinline__ void conv_item(const KP& p, const Ctx& c, int j) {
    const int b = j / 80, r = j % 80;
    const float* src; bf16* dst; size_t off;
    if (r < 32) { src = p.cfk + (size_t)b * 4096 * 512; dst = (bf16*)(p.ws + WS_FKA) + (size_t)b * KVS * 512; off = (size_t)r * 65536; }
    else if (r < 64) { src = p.cfv + (size_t)b * 4096 * 512; dst = (bf16*)(p.ws + WS_FVA) + (size_t)b * KVS * 512; off = (size_t)(r - 32) * 65536; }
    else if (r < 72) { src = p.cdk + (size_t)b * 4096 * 128; dst = (bf16*)(p.ws + WS_DKA) + (size_t)b * KVS * 128; off = (size_t)(r - 64) * 65536; }
    else { src = p.cdv + (size_t)b * 4096 * 128; dst = (bf16*)(p.ws + WS_DVA) + (size_t)b * KVS * 128; off = (size_t)(r - 72) * 65536; }
    src += off + (size_t)c.tid * 8; dst += off + (size_t)c.tid * 8;
#pragma unroll 1
    for (int i0 = 0; i0 < 16; i0 += 4) {
        f32x4 a[4], bb[4];
#pragma unroll
        for (int u = 0; u < 4; ++u) { a[u] = *(const f32x4*)(src + (size_t)(i0 + u) * 4096); bb[u] = *(const f32x4*)(src + (size_t)(i0 + u) * 4096 + 4); }
#pragma unroll
        for (int u = 0; u < 4; ++u) { u32x4 o; o.x = pk2(a[u][0], a[u][1]); o.y = pk2(a[u][2], a[u][3]); o.z = pk2(bb[u][0], bb[u][1]); o.w = pk2(bb[u][2], bb[u][3]); *(u32x4*)(dst + (size_t)(i0 + u) * 4096) = o; }
    }
}
__device__ __forceinline__ unsigned f2key(float f) { const unsigned u = __float_as_uint(f); return (u & 0x80000000u) ? ~u : (u | 0x80000000u); }
__device__ __forceinline__ int crow(int r, int hi) { return (r & 3) + 8 * (r >> 2) + 4 * hi; }

__device__ __forceinline__ int count8_ge(unsigned mid, unsigned k0, unsigned k1, unsigned k2, unsigned k3, unsigned k4, unsigned k5, unsigned k6, unsigned k7) {
    unsigned long long m0, m1, m2, m3, m4, m5, m6, m7;
    asm("v_cmp_le_u32_e64 %0, %8, %9\n\tv_cmp_le_u32_e64 %1, %8, %10\n\tv_cmp_le_u32_e64 %2, %8, %11\n\tv_cmp_le_u32_e64 %3, %8, %12\n\t"
        "v_cmp_le_u32_e64 %4, %8, %13\n\tv_cmp_le_u32_e64 %5, %8, %14\n\tv_cmp_le_u32_e64 %6, %8, %15\n\tv_cmp_le_u32_e64 %7, %8, %16"
        : "=&s"(m0), "=&s"(m1), "=&s"(m2), "=&s"(m3), "=&s"(m4), "=&s"(m5), "=&s"(m6), "=&s"(m7)
        : "s"(mid), "v"(k0), "v"(k1), "v"(k2), "v"(k3), "v"(k4), "v"(k5), "v"(k6), "v"(k7));
    return (__popcll(m0) + __popcll(m1)) + (__popcll(m2) + __popcll(m3)) + ((__popcll(m4) + __popcll(m5)) + (__popcll(m6) + __popcll(m7)));
}
template <int L0> __device__ __forceinline__ void words8_ge(unsigned t, int& wlo, int& whi, unsigned k0, unsigned k1, unsigned k2, unsigned k3, unsigned k4, unsigned k5, unsigned k6, unsigned k7) {
    unsigned long long m0, m1, m2, m3, m4, m5, m6, m7;
    asm volatile("v_cmp_le_u32_e64 %0, %8, %9\n\tv_cmp_le_u32_e64 %1, %8, %10\n\tv_cmp_le_u32_e64 %2, %8, %11\n\tv_cmp_le_u32_e64 %3, %8, %12\n\t"
        "v_cmp_le_u32_e64 %4, %8, %13\n\tv_cmp_le_u32_e64 %5, %8, %14\n\tv_cmp_le_u32_e64 %6, %8, %15\n\tv_cmp_le_u32_e64 %7, %8, %16"
        : "=&s"(m0), "=&s"(m1), "=&s"(m2), "=&s"(m3), "=&s"(m4), "=&s"(m5), "=&s"(m6), "=&s"(m7)
        : "s"(t), "v"(k0), "v"(k1), "v"(k2), "v"(k3), "v"(k4), "v"(k5), "v"(k6), "v"(k7));
#define WL_(m, L) asm volatile("v_writelane_b32 %0, %2, %4\n\tv_writelane_b32 %1, %3, %4" : "+v"(wlo), "+v"(whi) : "s"((int)(unsigned)(m)), "s"((int)(unsigned)((m) >> 32)), "n"(L))
    WL_(m0, L0); WL_(m1, L0 + 1); WL_(m2, L0 + 2); WL_(m3, L0 + 3); WL_(m4, L0 + 4); WL_(m5, L0 + 5); WL_(m6, L0 + 6); WL_(m7, L0 + 7);
#undef WL_
}
__device__ __forceinline__ void load_row(float (&v)[65], const float* row, int N, int lane) {
    const float* r0 = row + lane; asm volatile("" : "+v"(r0));
    const __attribute__((address_space(1))) float* r = (const __attribute__((address_space(1))) float*)r0;
#pragma unroll
    for (int j = 0; j < 8; ++j) if (512 * j < N) {
#pragma unroll
        for (int i = 8 * j; i < 8 * j + 8; ++i) v[i] = r[64 * i];
    }
    if (N > 4096) v[64] = r[4096];
}
__device__ __forceinline__ void keys_from_row(unsigned (&key)[65], const float (&v)[65], int N, int lane) {
#pragma unroll
    for (int j = 0; j < 8; ++j) {
        if (512 * j < N) {
#pragma unroll
            for (int i = 8 * j; i < 8 * j + 8; ++i) key[i] = f2key(v[i]);
        } else {
#pragma unroll
            for (int i = 8 * j; i < 8 * j + 8; ++i) key[i] = 0u;
        }
    }
    key[64] = (N > 4096 && lane < N - 4096) ? f2key(v[64]) : 0u;
}
__device__ __forceinline__ void select_query(const unsigned (&key)[65], int N, unsigned long long* mrow, LAS unsigned long long* lw, int lane) {
    if (N <= 256) { mrow[lane] = (64 * lane < N) ? ~0ull : 0ull; return; }
    unsigned lo = 0u, hi = 0xFFFFFFFFu; int clo = N; bool exact = false;
    {
        unsigned mk = 0u;
#pragma unroll
        for (int j = 0; j < 8; ++j) if (512 * j < N) {
#pragma unroll
            for (int i = 8 * j; i < 8 * j + 8; ++i) mk = mk > key[i] ? mk : key[i];
        }
        mk = mk > key[64] ? mk : key[64];
        { auto rr = __builtin_amdgcn_permlane32_swap(mk, mk, false, false); mk = rr[0] > rr[1] ? rr[0] : rr[1]; }
        { auto rr = __builtin_amdgcn_permlane16_swap(mk, mk, false, false); mk = rr[0] > rr[1] ? rr[0] : rr[1]; }
        mk = row_max16(mk);
        mk = (unsigned)__builtin_amdgcn_readfirstlane((int)mk);
        if (mk != 0xFFFFFFFFu) hi = mk + 1u;
        if (mk >= 0x80000000u + (6u << 23)) {
            const unsigned lc = mk - (6u << 23); int cnt = 0;
#pragma unroll
            for (int j = 0; j < 8; ++j) if (512 * j < N) cnt += count8_ge(lc, key[8 * j], key[8 * j + 1], key[8 * j + 2], key[8 * j + 3], key[8 * j + 4], key[8 * j + 5], key[8 * j + 6], key[8 * j + 7]);
            if (N > 4096) cnt += __popcll(__ballot(key[64] >= lc));
            if (cnt >= 256) { lo = lc; clo = cnt; exact = (cnt == 256); }
        }
    }
    if (!exact) {
        int chi = 0; bool bis = false;
        for (;;) {
            const unsigned span = hi - lo;
            if (span <= 1u) break;
            unsigned mid = lo + (span >> 1);
            if (!bis && lo >= 0x80000000u) {
                const float lv = __uint_as_float(lo & 0x7FFFFFFFu), hv = __uint_as_float(hi & 0x7FFFFFFFu);
                const float lc = __log2f((float)clo), lh = __log2f(chi > 0 ? (float)chi : 0.5f);
                const float f = (lc - 8.0f) / (lc - lh);
                const unsigned g = __float_as_uint(lv + (hv - lv) * f) | 0x80000000u;
                mid = g <= lo ? lo + 1u : (g >= hi ? hi - 1u : g);
            }
            bis = !bis;
            int cnt = 0;
#pragma unroll
            for (int j = 0; j < 8; ++j) if (512 * j < N) cnt += count8_ge(mid, key[8 * j], key[8 * j + 1], key[8 * j + 2], key[8 * j + 3], key[8 * j + 4], key[8 * j + 5], key[8 * j + 6], key[8 * j + 7]);
            if (N > 4096) cnt += __popcll(__ballot(key[64] >= mid));
            if (cnt >= 256) { lo = mid; clo = cnt; if (cnt == 256) { exact = true; break; } } else { hi = mid; chi = cnt; }
        }
    }
    if (exact) {
        int wlo = 0, whi = 0;
#define W8_(j) if (512 * (j) < N) words8_ge<8 * (j)>(lo, wlo, whi, key[8 * (j)], key[8 * (j) + 1], key[8 * (j) + 2], key[8 * (j) + 3], key[8 * (j) + 4], key[8 * (j) + 5], key[8 * (j) + 6], key[8 * (j) + 7]);
        W8_(0) W8_(1) W8_(2) W8_(3) W8_(4) W8_(5) W8_(6) W8_(7)
#undef W8_
        mrow[lane] = ((unsigned long long)(unsigned)whi << 32) | (unsigned)wlo;
        if (N > 4096) { const unsigned long long w = __ballot(key[64] >= lo); if (lane == 0) mrow[64] = w; }
        return;
    } else {
        int cgt = 0;
#pragma unroll
        for (int j = 0; j < 9; ++j) if (512 * j < N) {
#pragma unroll
            for (int i = 8 * j; i < 8 * j + 8 && i < 65; ++i) cgt += __popcll(__ballot(key[i] > lo));
        }
        const int need = 256 - cgt; int taken = 0; const unsigned long long lt = (1ull << lane) - 1ull;
#pragma unroll
        for (int j = 0; j < 9; ++j) if (512 * j < N) {
#pragma unroll
            for (int i = 8 * j; i < 8 * j + 8 && i < 65; ++i) {
                const bool gt = key[i] > lo, eq = key[i] == lo;
                const unsigned long long tb = __ballot(eq);
                const int rank = taken + __popcll(tb & lt);
                const bool sel = gt || (eq && rank < need);
                taken += __popcll(tb);
                const unsigned long long w = __ballot(sel);
                if (lane == 0) lw[i] = w;
            }
        }
    }
    (void)clo;
    LDS_WAIT();
    const int nw = (N + 63) >> 6;
    if (lane < nw) mrow[lane] = lw[lane];
    if (lane == 0 && nw > 64) mrow[64] = lw[64];
    LDS_WAIT();
}

__device__ __forceinline__ void idx_unit(const KP& p, const Ctx& c, int b, int ch, int half, float* scr) {
    const int lane = c.lane, wid = c.wid, r32 = lane & 31, hi = lane >> 5;
    const bool samp = ch < 0;
    const int N = samp ? NKEY_S : 64 * (ch + 1);
    const size_t qrow0 = samp ? (size_t)MP + b * 32 : (size_t)b * 4096 + 64 * ch + 32 * half;
    const bf16* ikb = samp ? (const bf16*)(p.ws + WS_IKA) + (size_t)b * KVS * 64 : (const bf16*)(p.ws + WS_IKP) + (size_t)b * 4096 * 64;
    const int nst = N / 32;
    {
        bf16x8 qf[4][4]; const bf16* qp = (const bf16*)(p.ws + WS_IQ) + (qrow0 + r32) * 256 + hi * 8;
#pragma unroll
        for (int h = 0; h < 4; ++h)
#pragma unroll
            for (int ks = 0; ks < 4; ++ks) qf[h][ks] = *(const bf16x8*)(qp + h * 64 + ks * 16);
        f32x4 wq[16];
#pragma unroll
        for (int r = 0; r < 16; ++r) wq[r] = *(const f32x4*)((const float*)(p.ws + WS_IW) + (qrow0 + crow(r, hi)) * 4);
        bf16x8 a[4];
        if (wid < nst) { const bf16* kp = ikb + (size_t)(32 * wid + r32) * 64 + hi * 8;
#pragma unroll
          for (int ks = 0; ks < 4; ++ks) a[ks] = *(const bf16x8*)(kp + ks * 16); }
        for (int st = wid; st < nst; st += 8) {
            bf16x8 an[4];
            if (st + 8 < nst) { const bf16* kp = ikb + (size_t)(32 * (st + 8) + r32) * 64 + hi * 8;
#pragma unroll
                for (int ks = 0; ks < 4; ++ks) an[ks] = *(const bf16x8*)(kp + ks * 16); }
            f32x16 sc;
#pragma unroll
            for (int r = 0; r < 16; ++r) sc[r] = 0.f;
#pragma unroll
            for (int h = 0; h < 4; ++h) { f32x16 d;
#pragma unroll
                for (int r = 0; r < 16; ++r) d[r] = 0.f;
#pragma unroll
                for (int ks = 0; ks < 4; ++ks) d = __builtin_amdgcn_mfma_f32_32x32x16_bf16(qf[h][ks], a[ks], d, 0, 0, 0);
#pragma unroll
                for (int r = 0; r < 16; ++r) sc[r] += wq[r][h] * (d[r] > 0.f ? d[r] : 0.f); }
            float* sp = scr + (size_t)(4 * hi) * SCR_LD + 32 * st + r32;
#pragma unroll
            for (int r = 0; r < 16; ++r) sp[(size_t)((r & 3) + 8 * (r >> 2)) * SCR_LD] = sc[r];
            if (st + 8 < nst) {
#pragma unroll
                for (int ks = 0; ks < 4; ++ks) a[ks] = an[ks]; }
        }
    }
    if (N < 4096 && (N & 511)) {
        const int pad = 512 - (N & 511);
        for (int rr = wid; rr < 32; rr += 8) for (int kk = lane; kk < pad; kk += 64) scr[(size_t)rr * SCR_LD + N + kk] = -INFINITY;
    }
    __syncthreads();
    {
        float v[65];
        load_row(v, scr + (size_t)wid * SCR_LD, N, lane);
#pragma unroll 1
        for (int q = wid; q < 32; q += 8) {
            unsigned key[65];
            keys_from_row(key, v, N, lane);
            if (q + 8 < 32) load_row(v, scr + (size_t)(q + 8) * SCR_LD, N, lane);
            select_query(key, N, (unsigned long long*)(p.ws + WS_MASK) + (qrow0 + q) * MW, (LAS unsigned long long*)(c.lds + wid * 1024), lane);
        }
    }
    __syncthreads();
}

struct FU {
    const bf16* q; const bf16* kbase; const bf16* vbase; const float* bias; const unsigned long long* mask; bf16* o;
    int kvstride, ntiles, qpos, causal_from, wave_qmax, t_begin; bool valid;
};
constexpr int FT_ROW = 144, FT_VROW = 192  , FT_V = 64 * FT_ROW, FT_BIAS = FT_V + 64 * FT_VROW, FT_BUF = FT_BIAS + 256;
__device__ __forceinline__ s16x4 vtr(const LAS unsigned char* p) { return __builtin_bit_cast(s16x4, __builtin_amdgcn_ds_read_tr16_b64_v4i16((LAS s16x4*)p)); }

constexpr float FOX_THR = 24.f;
__device__ __forceinline__ float vmax3(float a, float b, float c) { float r; asm("v_max3_f32 %0, %1, %2, %3" : "=v"(r) : "v"(a), "v"(b), "v"(c)); return r; }
__device__ __forceinline__ float vmax2(float a, float b) { float r; asm("v_max_f32_e32 %0, %1, %2" : "=v"(r) : "v"(a), "v"(b)); return r; }
template <int BP> __device__ __forceinline__ unsigned bitmask1(int w) { int r; asm("v_bfe_i32 %0, %1, %2, 1" : "=v"(r) : "v"(w), "n"(BP)); return (unsigned)r; }
__device__ __forceinline__ void flash_tile(const FU& u, const LAS unsigned char* Kb, int t, unsigned long long mw, const bf16x8 (&qr)[4], float& m, f32x16& negm, float& l, f32x16& o0, f32x16& o1, int r32, int hi, int vlane) {
            const LAS unsigned char* Vb = Kb + FT_V;
            f32x16 c0, c1;
            if (u.bias) { const LAS float* bl = (const LAS float*)(Kb + FT_BIAS);
#pragma unroll
                for (int g = 0; g < 4; ++g) { const f32x4 t0 = *(const LAS f32x4*)(bl + 8 * g + 4 * hi), t1 = *(const LAS f32x4*)(bl + 32 + 8 * g + 4 * hi);
#pragma unroll
                    for (int j = 0; j < 4; ++j) { c0[4 * g + j] = t0[j] - m; c1[4 * g + j] = t1[j] - m; } }
            } else { c0 = negm; c1 = negm; }
#pragma unroll
            for (int ks = 0; ks < 4; ++ks) {
                const bf16x8 a0 = *(const LAS bf16x8*)(Kb + r32 * FT_ROW + ks * 32 + hi * 16), a1 = *(const LAS bf16x8*)(Kb + (32 + r32) * FT_ROW + ks * 32 + hi * 16);
                c0 = __builtin_amdgcn_mfma_f32_32x32x16_bf16(a0, qr[ks], c0, 0, 0, 0); c1 = __builtin_amdgcn_mfma_f32_32x32x16_bf16(a1, qr[ks], c1, 0, 0, 0);
            }
            if (t >= u.causal_from) { const int kb = 64 * t + 4 * hi;
#pragma unroll
                for (int r = 0; r < 16; ++r) { const int kv = kb + (r & 3) + 8 * (r >> 2); if (kv > u.qpos) c0[r] = -INFINITY; if (kv + 32 > u.qpos) c1[r] = -INFINITY; } }
            asm volatile("s_nop 15\n\ts_nop 7" : "+v"(c0), "+v"(c1));
            float ma = vmax3(c0[0], c0[1], c1[0]), mb = vmax3(c0[2], c0[3], c1[1]); ma = vmax3(ma, c1[2], c1[3]);
#pragma unroll
            for (int r = 4; r < 16; r += 4) { ma = vmax3(ma, c0[r], c0[r + 1]); mb = vmax3(mb, c0[r + 2], c0[r + 3]); ma = vmax3(ma, c1[r], c1[r + 1]); mb = vmax3(mb, c1[r + 2], c1[r + 3]); }
            float mx = vmax2(ma, mb); { auto rr = __builtin_amdgcn_permlane32_swap(__float_as_uint(mx), __float_as_uint(mx), false, false); mx = vmax2(__uint_as_float(rr[0]), __uint_as_float(rr[1])); }
            if (u.bias && !__any(mx > -FOX_THR)) return;
            if (__any(mx > 0.f)) {
                const float dl = vmax2(mx, 0.f), al = __builtin_amdgcn_exp2f(-dl); m += dl; l *= al;
#pragma unroll
                for (int r = 0; r < 16; ++r) { o0[r] *= al; o1[r] *= al; c0[r] -= dl; c1[r] -= dl; negm[r] = -m; }
            }
#pragma unroll
            for (int r = 0; r < 16; ++r) { c0[r] = __builtin_amdgcn_exp2f(c0[r]); c1[r] = __builtin_amdgcn_exp2f(c1[r]); }
            if (u.mask) {
                const int lo = (int)((unsigned)mw >> (4 * hi)), hw = (int)((unsigned)(mw >> 32) >> (4 * hi));
#define MK(r) { c0[r] = __uint_as_float(__float_as_uint(c0[r]) & bitmask1<((r) & 3) + 8 * ((r) >> 2)>(lo)); c1[r] = __uint_as_float(__float_as_uint(c1[r]) & bitmask1<((r) & 3) + 8 * ((r) >> 2)>(hw)); }
                MK(0) MK(1) MK(2) MK(3) MK(4) MK(5) MK(6) MK(7) MK(8) MK(9) MK(10) MK(11) MK(12) MK(13) MK(14) MK(15)
#undef MK
            }
            float ps = 0.f;
#pragma unroll
            for (int r = 0; r < 16; ++r) ps += c0[r] + c1[r];
            l += ps;
            bf16x8 pf[4];
#pragma unroll
            for (int s = 0; s < 2; ++s) {
                u32x4 w0, w1;
                w0.x = pk2(c0[8 * s + 0], c0[8 * s + 1]); w0.y = pk2(c0[8 * s + 2], c0[8 * s + 3]); w0.z = pk2(c0[8 * s + 4], c0[8 * s + 5]); w0.w = pk2(c0[8 * s + 6], c0[8 * s + 7]);
                w1.x = pk2(c1[8 * s + 0], c1[8 * s + 1]); w1.y = pk2(c1[8 * s + 2], c1[8 * s + 3]); w1.z = pk2(c1[8 * s + 4], c1[8 * s + 5]); w1.w = pk2(c1[8 * s + 6], c1[8 * s + 7]);
                pf[s] = __builtin_bit_cast(bf16x8, w0); pf[2 + s] = __builtin_bit_cast(bf16x8, w1);
            }
            const LAS unsigned char* vp = Vb + vlane;
#pragma unroll
            for (int s = 0; s < 4; ++s) {
                const s16x4 a_lo0 = vtr(vp + (16 * s) * FT_VROW), a_hi0 = vtr(vp + (16 * s + 8) * FT_VROW);
                const s16x4 a_lo1 = vtr(vp + (16 * s) * FT_VROW + 64), a_hi1 = vtr(vp + (16 * s + 8) * FT_VROW + 64);
                const bf16x8 A0 = (bf16x8){a_lo0[0], a_lo0[1], a_lo0[2], a_lo0[3], a_hi0[0], a_hi0[1], a_hi0[2], a_hi0[3]};
                const bf16x8 A1 = (bf16x8){a_lo1[0], a_lo1[1], a_lo1[2], a_lo1[3], a_hi1[0], a_hi1[1], a_hi1[2], a_hi1[3]};
                o0 = __builtin_amdgcn_mfma_f32_32x32x16_bf16(A0, pf[s], o0, 0, 0, 0); o1 = __builtin_amdgcn_mfma_f32_32x32x16_bf16(A1, pf[s], o1, 0, 0, 0);
            }
}
__device__ __forceinline__ void flash_unit(const FU& u, const Ctx& c) {
    const int tid = c.tid, lane = c.lane, r32 = lane & 31, hi = lane >> 5;
    LAS unsigned char* lds = c.lds;
    const int lrow = tid >> 3, lch = tid & 7;
    const bf16* kg = u.kbase + (size_t)lrow * u.kvstride + lch * 8;
    const bf16* vg = u.vbase + (size_t)lrow * u.kvstride + lch * 8;
    const size_t tstep = (size_t)64 * u.kvstride;
    const int loff = lrow * FT_ROW + lch * 16, loffv = lrow * FT_VROW + lch * 16;
    const int t0 = u.t_begin, tl = u.ntiles - 1, n = tl - t0 + 1;
    u32x4 kA, vA, kB, vB; float bA = 0.f, bB = 0.f; unsigned long long mA = 0ull, mB = 0ull, mC = 0ull;
#define FL_BAR() asm volatile("s_waitcnt lgkmcnt(0)\n\ts_barrier" ::: "memory")
#define FL_LOAD(S, tt) do { k##S = *(const u32x4*)(kg + (size_t)(tt) * tstep); v##S = *(const u32x4*)(vg + (size_t)(tt) * tstep); if (u.bias) b##S = u.bias[(tt) * 64 + (tid & 63)]; if (u.mask) m##S = u.mask[tt]; } while (0)
#define FL_STORE(bufi, S) do { LAS unsigned char* nb_ = lds + (bufi) * FT_BUF; *(LAS u32x4*)(nb_ + loff) = k##S; *(LAS u32x4*)(nb_ + FT_V + loffv) = v##S; if (tid < 64) *(LAS float*)(nb_ + FT_BIAS + tid * 4) = b##S; } while (0)
    FL_LOAD(A, tl); FL_LOAD(B, (tl - 1 > t0 ? tl - 1 : t0));
    bf16x8 qr[4];
    if (u.valid) {
#pragma unroll
        for (int ks = 0; ks < 4; ++ks) qr[ks] = *(const bf16x8*)(u.q + ks * 16 + hi * 8);
    }
    FL_STORE(0, A); FL_STORE(1, B); mC = mA; unsigned long long mD = mB;
    float m = 0.f, l = 0.f; f32x16 o0, o1, negm;
#pragma unroll
    for (int r = 0; r < 16; ++r) { o0[r] = 0.f; o1[r] = 0.f; negm[r] = 0.f; }
    const int vlane = (4 * hi + ((lane & 15) >> 2)) * FT_VROW + (16 * ((lane >> 4) & 1) + 4 * (lane & 3)) * 2;
    FL_BAR();
    for (int i = 0; i < n; i += 2) {
        const int ta = tl - i, tb = tl - i - 1;
        { const int tn = tl - i - 2, tm = tl - i - 3; FL_LOAD(A, (tn > t0 ? tn : t0)); FL_LOAD(B, (tm > t0 ? tm : t0)); }
        if (u.valid && !(ta >= u.causal_from && 64 * ta > u.wave_qmax)) flash_tile(u, lds, ta, mC, qr, m, negm, l, o0, o1, r32, hi, vlane);
        if (tb >= t0 && u.valid && !(tb >= u.causal_from && 64 * tb > u.wave_qmax)) flash_tile(u, lds + FT_BUF, tb, mD, qr, m, negm, l, o0, o1, r32, hi, vlane);
        FL_BAR();
        FL_STORE(0, A); FL_STORE(1, B); mC = mA; mD = mB;
        FL_BAR();
    }
#undef FL_LOAD
#undef FL_BAR
#undef FL_STORE
    if (u.valid) {
        l = pg8::add_xor32(l); const float inv = 1.0f / l;
#pragma unroll
        for (int g = 0; g < 4; ++g) {
            u32x2 w0, w1;
            w0.x = pk2(o0[4 * g] * inv, o0[4 * g + 1] * inv); w0.y = pk2(o0[4 * g + 2] * inv, o0[4 * g + 3] * inv);
            w1.x = pk2(o1[4 * g] * inv, o1[4 * g + 1] * inv); w1.y = pk2(o1[4 * g + 2] * inv, o1[4 * g + 3] * inv);
            *(u32x2*)(u.o + 8 * g + 4 * hi) = w0; *(u32x2*)(u.o + 32 + 8 * g + 4 * hi) = w1;
        }
    }
}

__device__ __forceinline__ int fox_first_tile(const unsigned* nrm, const float* bias, int row0, int ntl, int lane) {
    const float q2 = __uint_as_float(nrm[0]), k2 = __uint_as_float(nrm[1]);
    const float slack = 2.0f * sqrtf(q2 * k2) * 1.01f + FOX_THR - bias[row0];
    const bool skip = (lane < ntl) && (slack + bias[64 * (lane < ntl ? lane : 0) + 63] < 0.f);
    const unsigned long long bal = __ballot(skip);
    const int t0 = __ffsll((long long)~bal) - 1;
    return (~bal == 0ull) ? ntl : (t0 < ntl ? t0 : ntl);
}
__device__ __forceinline__ void attn_fox_p(const KP& p, const Ctx& c, int b, int h, int qb) {
    const int r32 = c.lane & 31; const int pos = 256 * qb + 32 * c.wid + r32; const size_t row = (size_t)b * 4096 + pos;
    FU u; u.q = (const bf16*)(p.ws + WS_FQ) + row * 512 + h * 64; u.kbase = (const bf16*)(p.ws + WS_FKP) + (size_t)b * 4096 * 512 + h * 64; u.vbase = (const bf16*)(p.ws + WS_FVP) + (size_t)b * 4096 * 512 + h * 64;
    u.bias = (const float*)(p.ws + WS_BIASP) + (size_t)(b * 8 + h) * SEQ; u.mask = nullptr; u.o = (bf16*)(p.ws + WS_AO) + row * DM + h * 64;
    u.kvstride = 512; u.ntiles = 4 * qb + 4; u.qpos = pos; u.causal_from = 4 * qb; u.wave_qmax = 256 * qb + 32 * c.wid + 31; u.valid = true;
    u.t_begin = fox_first_tile((const unsigned*)(p.ws + WS_NORM) + (b * 8 + h) * 2, u.bias, 256 * qb, 4 * qb, c.lane);
    flash_unit(u, c);
}
__device__ __forceinline__ void attn_fox_s(const KP& p, const Ctx& c, int b, int h) {
    const int r32 = c.lane & 31; const size_t row = (size_t)MP + b * 32 + r32;
    FU u; u.q = (const bf16*)(p.ws + WS_FQ) + row * 512 + h * 64; u.kbase = (const bf16*)(p.ws + WS_FKA) + (size_t)b * KVS * 512 + h * 64; u.vbase = (const bf16*)(p.ws + WS_FVA) + (size_t)b * KVS * 512 + h * 64;
    u.bias = (const float*)(p.ws + WS_BIASS) + (size_t)(b * 8 + h) * KVS; u.mask = nullptr; u.o = (bf16*)(p.ws + WS_AO) + row * DM + h * 64;
    u.kvstride = 512; u.ntiles = 65; u.qpos = 4096 + r32; u.causal_from = 64; u.wave_qmax = 4127; u.valid = (c.wid == 0);
    u.t_begin = fox_first_tile((const unsigned*)(p.ws + WS_NORM) + ((16 + b) * 8 + h) * 2, u.bias, 4096, 64, c.lane);
    flash_unit(u, c);
}
__device__ __forceinline__ void attn_dsa_p(const KP& p, const Ctx& c, int b, int ch, int g) {
    const int r32 = c.lane & 31; const int hh = 4 * g + (c.wid >> 1); const size_t row = (size_t)b * 4096 + 64 * ch + 32 * (c.wid & 1) + r32;
    FU u; u.q = (const bf16*)(p.ws + WS_DQ) + row * 512 + hh * 64; u.kbase = (const bf16*)(p.ws + WS_DKP) + (size_t)b * 4096 * 128 + g * 64; u.vbase = (const bf16*)(p.ws + WS_DVP) + (size_t)b * 4096 * 128 + g * 64;
    u.bias = nullptr; u.mask = (const unsigned long long*)(p.ws + WS_MASK) + row * MW; u.o = (bf16*)(p.ws + WS_AO) + row * DM + 512 + hh * 64;
    u.kvstride = 128; u.ntiles = ch + 1; u.qpos = 0; u.causal_from = ch + 1; u.wave_qmax = 0; u.valid = true; u.t_begin = 0;
    flash_unit(u, c);
}
__device__ __forceinline__ void attn_dsa_s(const KP& p, const Ctx& c, int b, int g) {
    const int r32 = c.lane & 31; const int hh = 4 * g + (c.wid & 3); const size_t row = (size_t)MP + b * 32 + r32;
    FU u; u.q = (const bf16*)(p.ws + WS_DQ) + row * 512 + hh * 64; u.kbase = (const bf16*)(p.ws + WS_DKA) + (size_t)b * KVS * 128 + g * 64; u.vbase = (const bf16*)(p.ws + WS_DVA) + (size_t)b * KVS * 128 + g * 64;
    u.bias = nullptr; u.mask = (const unsigned long long*)(p.ws + WS_MASK) + row * MW; u.o = (bf16*)(p.ws + WS_AO) + row * DM + 512 + hh * 64;
    u.kvstride = 128; u.ntiles = 65; u.qpos = 0; u.causal_from = 65; u.wave_qmax = 0; u.valid = (c.wid < 4); u.t_begin = 0;
    flash_unit(u, c);
}

__device__ __forceinline__ void ln1_apply(const Ctx& c, const float* z, const float* stats, const float* gam, const float* bet, bf16* outb, float* rowstat) {
    for (int row0 = c.gw; row0 < MT; row0 += 2 * c.ngw) {
        float s[2], q[2]; f32x4 v[2][4];
#pragma unroll
        for (int e = 0; e < 2; ++e) { const int row = row0 + e * c.ngw < MT ? row0 + e * c.ngw : row0;
            s[e] = 0.f; q[e] = 0.f; if (c.lane < 16) { const float* sp = stats + ((size_t)row * 16 + c.lane) * 2; s[e] = sp[0]; q[e] = sp[1]; }
            const float* zr = z + (size_t)row * DM;
#pragma unroll
            for (int j = 0; j < 4; ++j) v[e][j] = *(const f32x4*)(zr + 256 * j + 4 * c.lane); }
#pragma unroll
        for (int e = 0; e < 2; ++e) { const int row = row0 + e * c.ngw; if (row < MT) {
            float ss = s[e], qq = q[e];
            ss = __builtin_amdgcn_readfirstlane(row_sum16(ss)); qq = __builtin_amdgcn_readfirstlane(row_sum16(qq));
            const float mean = ss * (1.f / DM), var = fmaxf(qq * (1.f / DM) - mean * mean, 0.f), rstd = 1.0f / sqrtf(var + LN_EPS);
            if (c.lane == 0) { rowstat[2 * (size_t)row] = mean; rowstat[2 * (size_t)row + 1] = rstd; }
#pragma unroll
            for (int j = 0; j < 4; ++j) { const int col = 256 * j + 4 * c.lane;
                const f32x4 gg = *(const f32x4*)(gam + col), bb = *(const f32x4*)(bet + col);
                const f32x4 o = (v[e][j] - mean) * rstd * gg + bb;
                u32x2 w; w.x = pk2(o[0], o[1]); w.y = pk2(o[2], o[3]); *(u32x2*)(outb + (size_t)row * DM + col) = w; } } }
    }
}
__device__ __forceinline__ void ln2_apply(const Ctx& c, const bf16* z2b, const float* stats, const float* gam, const float* bet, float* outf) {
    for (int row0 = c.gw; row0 < MT; row0 += 2 * c.ngw) {
        float s[2], q[2]; u32x2 v[2][4];
#pragma unroll
        for (int e = 0; e < 2; ++e) { const int row = row0 + e * c.ngw < MT ? row0 + e * c.ngw : row0;
            s[e] = 0.f; q[e] = 0.f; if (c.lane < 16) { const float* sp = stats + ((size_t)row * 16 + c.lane) * 2; s[e] = sp[0]; q[e] = sp[1]; }
            const bf16* zr = z2b + (size_t)row * DM;
#pragma unroll
            for (int j = 0; j < 4; ++j) v[e][j] = *(const u32x2*)(zr + 256 * j + 4 * c.lane); }
#pragma unroll
        for (int e = 0; e < 2; ++e) { const int row = row0 + e * c.ngw; if (row < MT) {
            float ss = s[e], qq = q[e];
            ss = __builtin_amdgcn_readfirstlane(row_sum16(ss)); qq = __builtin_amdgcn_readfirstlane(row_sum16(qq));
            const float mean = ss * (1.f / DM), var = fmaxf(qq * (1.f / DM) - mean * mean, 0.f), rstd = 1.0f / sqrtf(var + LN_EPS);
#pragma unroll
            for (int j = 0; j < 4; ++j) { const int col = 256 * j + 4 * c.lane;
                const f32x4 gg = *(const f32x4*)(gam + col), bb = *(const f32x4*)(bet + col);
                const f32x4 x = (f32x4){__uint_as_float(v[e][j].x << 16), __uint_as_float(v[e][j].x & 0xFFFF0000u), __uint_as_float(v[e][j].y << 16), __uint_as_float(v[e][j].y & 0xFFFF0000u)};
                *(f32x4*)(outf + (size_t)row * DM + col) = (x - mean) * rstd * gg + bb; } } }
    }
}

struct MiniArgs { const bf16* A; const bf16* Bt; int K; const float* xs; float* z; float* stats; bf16* act; const float* rowstat; const float* g1; const float* b1; bf16* z2b; };
template <int MODE> __device__ __forceinline__ void mini_tile(const MiniArgs& a, const Ctx& c, int rt, int ct) {
    const int lane = c.lane, wid = c.wid, r32 = lane & 31, hi = lane >> 5;
    const int row0 = MP + 32 * rt;
    const int brow0 = MODE == 1 ? 256 * (ct >> 2) + 32 * (ct & 3) : 64 * ct, brow1 = MODE == 1 ? brow0 + 128 : brow0 + 32;
    const int K = a.K, nks = K / 16;
    const bf16* ap = a.A + (size_t)(row0 + r32) * K + 8 * hi;
    const bf16* b0p = a.Bt + (size_t)(brow0 + r32) * K + 8 * hi;
    const bf16* b1p = a.Bt + (size_t)(brow1 + r32) * K + 8 * hi;
    f32x16 c0, c1;
#pragma unroll
    for (int r = 0; r < 16; ++r) { c0[r] = 0.f; c1[r] = 0.f; }
    for (int ks0 = wid; ks0 < nks; ks0 += 32) {
        bf16x8 av[4], bv0[4], bv1[4];
#pragma unroll
        for (int u = 0; u < 4; ++u) { const int ks = ks0 + 8 * u; const int kc = ks < nks ? ks : ks0; av[u] = *(const bf16x8*)(ap + 16 * kc); bv0[u] = *(const bf16x8*)(b0p + 16 * kc); bv1[u] = *(const bf16x8*)(b1p + 16 * kc); }
#pragma unroll
        for (int u = 0; u < 4; ++u) if (ks0 + 8 * u < nks) { c0 = __builtin_amdgcn_mfma_f32_32x32x16_bf16(av[u], bv0[u], c0, 0, 0, 0); c1 = __builtin_amdgcn_mfma_f32_32x32x16_bf16(av[u], bv1[u], c1, 0, 0, 0); }
    }
    LAS float* red = (LAS float*)c.lds;
#pragma unroll
    for (int r = 0; r < 16; ++r) { red[((wid * 2 + 0) * 16 + r) * 64 + lane] = c0[r]; red[((wid * 2 + 1) * 16 + r) * 64 + lane] = c1[r]; }
    __syncthreads();
#pragma unroll
    for (int e = 0; e < 2; ++e) {
        const int r = 2 * wid + e; float v0 = 0.f, v1 = 0.f;
#pragma unroll
        for (int w = 0; w < 8; ++w) { v0 += red[((w * 2 + 0) * 16 + r) * 64 + lane]; v1 += red[((w * 2 + 1) * 16 + r) * 64 + lane]; }
        const int row = row0 + (r & 3) + 8 * (r >> 2) + 4 * hi;
        if (MODE == 1) {
            const float g = v0; const float o = g * __builtin_amdgcn_rcpf(1.f + __expf(-g)) * v1;
            a.act[(size_t)row * DFF + 32 * ct + r32] = (bf16)(pk2(o, 0.f) & 0xFFFFu);
        } else {
            const int col = 64 * ct + r32; float z0, z1;
            if (MODE == 0) { const float* xr = a.xs + (size_t)(row - MP) * DM + col; z0 = xr[0] * ALPHA + v0; z1 = xr[32] * ALPHA + v1; float* zr = a.z + (size_t)row * DM + col; zr[0] = z0; zr[32] = z1; }
            else { const float mean = a.rowstat[2 * (size_t)row], rstd = a.rowstat[2 * (size_t)row + 1]; const float* zr = a.z + (size_t)row * DM + col;
                   const float h0 = (zr[0] - mean) * rstd * a.g1[col] + a.b1[col], h1 = (zr[32] - mean) * rstd * a.g1[col + 32] + a.b1[col + 32];
                   z0 = h0 * ALPHA + v0; z1 = h1 * ALPHA + v1; bf16* o = a.z2b + (size_t)row * DM + col; o[0] = (bf16)(pk2(z0, 0.f) & 0xFFFFu); o[32] = (bf16)(pk2(z1, 0.f) & 0xFFFFu); }
            float sm = z0 + z1, sq = z0 * z0 + z1 * z1;
#pragma unroll
            for (int o = 0; o < 1; ++o) { sm = pg8::add_xor16(row_sum16(sm)); sq = pg8::add_xor16(row_sum16(sq)); }
            if (r32 == 0) { float* sp = a.stats + ((size_t)row * 16 + ct) * 2; sp[0] = sm; sp[1] = sq; }
        }
    }
    __syncthreads();
}
template <int MODE> __device__ __forceinline__ void mini_phase(const MiniArgs& a, const Ctx& c, int nct, int G, int bx) {
#pragma unroll 1
    for (int t = bx; t < 8 * nct; t += G) mini_tile<MODE>(a, c, t / nct, t % nct);
}

#ifndef REP_P2
#define REP_P2 1
#endif
#ifndef REP_FOX
#define REP_FOX 1
#endif
#ifndef REP_DSA
#define REP_DSA 1
#endif
constexpr int LDS_BYTES = pg8::STAGE_BYTES;
__global__ void __launch_bounds__(512, 2) fox_dsa_fwd(KP p) {
    extern __shared__ __attribute__((aligned(16))) unsigned char lds_raw[];
    cg::grid_group grid = cg::this_grid();
#define MKCTX() Ctx c; { int t_ = threadIdx.x; asm volatile("" : "+v"(t_)); c.tid = t_; c.lane = t_ & 63; c.wid = __builtin_amdgcn_readfirstlane(t_ >> 6); c.gw = blockIdx.x * 8 + c.wid; c.ngw = gridDim.x * 8; c.lds = (LAS unsigned char*)lds_raw; } \
    const int G = gridDim.x, bx = blockIdx.x; unsigned char* ws = p.ws; (void)G; (void)bx; (void)ws;

    { MKCTX();
    p0_prologue(p, c);
    }
    grid.sync();
    { MKCTX();
    { pg8::Gemm g{(const pg8::bf16_t*)(ws + WS_XB), (const pg8::bf16_t*)(ws + WS_WIN), MT, NIN, DM}; pg8::StaticOrder S; S.init(MT, NIN, G, bx);
      pg8::EpiIn E{p.out, ws, p.b_forget};
      pg8::gemm_phase<pg8::EpiIn, pg8::StaticOrder, true, true>(c.lds, g, S, E); }
    }
    grid.sync();
    { MKCTX();
    if (c.gw < 24) cumsum_item(p, c.gw, c.lane);
    for (int vb = bx; vb < 256; vb += G) {
        { const int bh = vb >> 1, r0 = (vb & 1) * 2048 + c.wid * 256; unsigned* nd = (unsigned*)(ws + WS_NORM) + bh * 2;
          norm_rows((const bf16*)(ws + WS_FQ) + (size_t)(bh >> 3) * 4096 * 512, r0, 256, bh & 7, nd, c.lane);
          norm_rows((const bf16*)(ws + WS_FKP) + (size_t)(bh >> 3) * 4096 * 512, r0, 256, bh & 7, nd + 1, c.lane); }
        if (vb < 64) { const int sb = vb >> 3, h = vb & 7; unsigned* nd = (unsigned*)(ws + WS_NORM) + ((16 + sb) * 8 + h) * 2;
          norm_rows_f32(p.cfk + (size_t)sb * 4096 * 512, c.wid * 512, 512, h, nd + 1, c.lane);
          if (c.wid == 1) norm_rows((const bf16*)(ws + WS_FKA) + (size_t)sb * KVS * 512, 4096, 32, h, nd + 1, c.lane);
          if (c.wid == 0) norm_rows((const bf16*)(ws + WS_FQ) + (size_t)(MP + sb * 32) * 512, 0, 32, h, nd, c.lane); }
    }
    { float* scr = (float*)(ws + WS_SCR) + (size_t)bx * 32 * SCR_LD;
      for (int rep = 0; rep < REP_P2; ++rep) {
      unsigned* qctr = (unsigned*)(ws + WS_NORM) + 1024 - 2 - 2 * rep;
      volatile LAS int* qsh = (volatile LAS int*)(c.lds + 60000);
      for (;;) {
          if (c.tid == 0) *qsh = (int)atomicAdd(qctr, 1u);
          __syncthreads();
          int idx = *qsh;
          __syncthreads();
          if (idx >= 8 + 2048 + 640) break;
          if (idx >= 8 + 2048) { conv_item(p, c, idx - (8 + 2048)); continue; }
          int ub, uc, uh; if (idx < 8) { ub = idx; uc = -1; uh = 0; } else { idx -= 8; ub = (idx & 31) >> 1; uc = 63 - (idx >> 5); uh = idx & 1; }
          idx_unit(p, c, ub, uc, uh, scr);
      } } }
    }
    grid.sync();
    { MKCTX();
      for (int rep = 0; rep < REP_FOX; ++rep) {
      unsigned* qctr = (unsigned*)(ws + WS_NORM) + 1024 - 1 - 2 * rep;
      if (c.wid >= 4) __builtin_amdgcn_s_setprio(1);
      volatile LAS int* qsh = (volatile LAS int*)(c.lds + 60000);
      for (;;) {
          if (c.tid == 0) *qsh = (int)atomicAdd(qctr, 1u);
          __syncthreads();
          int idx = *qsh;
          __syncthreads();
          if (idx >= 80 + 16 * 256) break;
          if (idx < 16) { attn_dsa_s(p, c, idx >> 1, idx & 1); continue; }
          if (idx < 80) { idx -= 16; attn_fox_s(p, c, idx >> 3, idx & 7); continue; }
          idx -= 80;
          const int k = 15 - (idx >> 8), r = idx & 255;
          if (r < 32) attn_dsa_p(p, c, r >> 1, 4 * k + 3, r & 1);
          else if (r < 160) { const int u = r - 32; attn_fox_p(p, c, u >> 3, u & 7, k); }
          else { const int u = r - 160, lv = u >> 5, w = u & 31; attn_dsa_p(p, c, w >> 1, 4 * k + 2 - lv, w & 1); }
      }
      __builtin_amdgcn_s_setprio(0); }
    }
    grid.sync();
    { MKCTX();
    { MiniArgs ma{}; ma.A = (const bf16*)(ws + WS_AO); ma.Bt = (const bf16*)(ws + WS_WO); ma.K = DM; ma.xs = p.xs; ma.z = (float*)(ws + WS_Z); ma.stats = (float*)(ws + WS_ST1);
      mini_phase<0>(ma, c, 16, G, bx); }
    { pg8::Gemm g{(const pg8::bf16_t*)(ws + WS_AO), (const pg8::bf16_t*)(ws + WS_WO), MP, DM, DM}; pg8::StaticOrder S; S.init(MP, DM, G, bx);
      pg8::EpiZ E{p.xp, p.xs, (float*)(ws + WS_Z), (float*)(ws + WS_ST1)};
      pg8::gemm_phase<pg8::EpiZ, pg8::StaticOrder, true, true>(c.lds, g, S, E); }
    }
    grid.sync();
    { MKCTX();
    ln1_apply(c, (const float*)(ws + WS_Z), (const float*)(ws + WS_ST1), p.ln1g, p.ln1b, (bf16*)(ws + WS_HB), (float*)(ws + WS_RS1));
    }
    grid.sync();
    { MKCTX();
    { MiniArgs ma{}; ma.A = (const bf16*)(ws + WS_HB); ma.Bt = (const bf16*)(ws + WS_WGU); ma.K = DM; ma.act = (bf16*)(ws + WS_ACT);
      mini_phase<1>(ma, c, 88, G, bx); }
    { pg8::Gemm g{(const pg8::bf16_t*)(ws + WS_HB), (const pg8::bf16_t*)(ws + WS_WGU), MP, NGU, DM}; pg8::StaticOrder S; S.init(MP, NGU, G, bx);
      pg8::EpiAct E{(pg8::bf16_t*)(ws + WS_ACT)};
      pg8::gemm_phase<pg8::EpiAct, pg8::StaticOrder, true, true>(c.lds, g, S, E); }
    }
    grid.sync();
    { MKCTX();
    { MiniArgs ma{}; ma.A = (const bf16*)(ws + WS_ACT); ma.Bt = (const bf16*)(ws + WS_WD); ma.K = DFF; ma.z = (float*)(ws + WS_Z); ma.stats = (float*)(ws + WS_ST2);
      ma.rowstat = (const float*)(ws + WS_RS1); ma.g1 = p.ln1g; ma.b1 = p.ln1b; ma.z2b = (bf16*)(ws + WS_Z2B);
      mini_phase<2>(ma, c, 16, G, bx); }
    { pg8::Gemm g{(const pg8::bf16_t*)(ws + WS_ACT), (const pg8::bf16_t*)(ws + WS_WD), MP, DM, DFF}; pg8::StaticOrder S; S.init(MP, DM, G, bx);
      pg8::EpiZ2 E{(const float*)(ws + WS_Z), (const float*)(ws + WS_RS1), p.ln1g, p.ln1b, (pg8::bf16_t*)(ws + WS_Z2B), (float*)(ws + WS_ST2)};
      pg8::gemm_phase<pg8::EpiZ2, pg8::StaticOrder, true, true>(c.lds, g, S, E); }
    }
    grid.sync();
    { MKCTX();
    ln2_apply(c, (const bf16*)(ws + WS_Z2B), (const float*)(ws + WS_ST2), p.ln2g, p.ln2b, p.out);
    }
}

extern "C" void kernel_launch(void* const* d_in, const int* in_sizes, int n_in, void* d_out, int out_size, void* d_ws, size_t ws_size, hipStream_t stream) {
    static int grid = 0;
    if (grid == 0) {
        if (n_in != 18 || (size_t)out_size != O_END || ws_size < WS_NEED) { fprintf(stderr, "kernel_launch: unexpected shapes (n_in %d out %d ws %zu need %zu)\n", n_in, out_size, ws_size, (size_t)WS_NEED); grid = -1; return; }
        int dev = 0, cus = 0, per_cu = 0;
        hipGetDevice(&dev); hipDeviceGetAttribute(&cus, hipDeviceAttributeMultiprocessorCount, dev);
        hipFuncSetAttribute((const void*)fox_dsa_fwd, hipFuncAttributeMaxDynamicSharedMemorySize, LDS_BYTES);
        if (hipOccupancyMaxActiveBlocksPerMultiprocessor(&per_cu, (const void*)fox_dsa_fwd, 512, LDS_BYTES) != hipSuccess || per_cu < 1) per_cu = 1;
        (void)hipGetLastError();
        grid = cus * 1;
        if (grid > 256) grid = 256;
    }
    if (grid < 0) return;
    KP p{};
    p.xp = (const float*)d_in[0]; p.xs = (const float*)d_in[1]; p.cfk = (const float*)d_in[2]; p.cfv = (const float*)d_in[3]; p.cflf = (const float*)d_in[4];
    p.cdk = (const float*)d_in[5]; p.cdv = (const float*)d_in[6]; p.cik = (const float*)d_in[7]; p.w_in = (const float*)d_in[8]; p.b_forget = (const float*)d_in[9];
    p.w_out = (const float*)d_in[10]; p.ln1g = (const float*)d_in[11]; p.ln1b = (const float*)d_in[12]; p.w_gate = (const float*)d_in[13]; p.w_up = (const float*)d_in[14];
    p.w_down = (const float*)d_in[15]; p.ln2g = (const float*)d_in[16]; p.ln2b = (const float*)d_in[17]; p.out = (float*)d_out; p.ws = (unsigned char*)d_ws;
    void* args[] = {&p};
    hipError_t e = hipLaunchCooperativeKernel((const void*)fox_dsa_fwd, dim3(grid), dim3(512), args, LDS_BYTES, stream);
    if (e != hipSuccess) fprintf(stderr, "cooperative launch failed: %s (grid %d)\n", hipGetErrorString(e), grid);
}
```

```cpp
#include <hip/hip_runtime.h>
#include <hip/hip_cooperative_groups.h>
#include <cstdio>
#include <cstdint>
namespace cg = cooperative_groups;

#define LAS __attribute__((address_space(3)))
typedef unsigned short bf16;
typedef short bf16x8 __attribute__((ext_vector_type(8)));
typedef float f32x4 __attribute__((ext_vector_type(4)));
typedef float f32x16 __attribute__((ext_vector_type(16)));
typedef unsigned u32x4 __attribute__((ext_vector_type(4)));
typedef unsigned u32x2 __attribute__((ext_vector_type(2)));
typedef short s16x4 __attribute__((ext_vector_type(4)));

constexpr int DM = 1024, SEQ = 4096, NBATCH = 16, MP = NBATCH * SEQ, DB = 8, DT = 32, MS = DB * DT, MT = MP + MS;
constexpr int KVS = 4160, NKEY_S = 4128;
constexpr int NIN = 2816, DFF = 2816, NGU = 5632;
constexpr int MW = 65;
constexpr int SCR_LD = 4160;
constexpr float ALPHA = 1.18920711500272f, LN_EPS = 1e-5f, LOG2E = 1.4426950408889634f, C2 = 0.125f * 1.4426950408889634f;

constexpr size_t O_YP = 0, O_YS = O_YP + (size_t)MP * DM, O_PFK = O_YS + (size_t)MS * DM, O_PFV = O_PFK + (size_t)MP * 512, O_PFLF = O_PFV + (size_t)MP * 512,
                 O_PDK = O_PFLF + (size_t)MP * 8, O_PDV = O_PDK + (size_t)MP * 128, O_PIK = O_PDV + (size_t)MP * 128, O_SFK = O_PIK + (size_t)MP * 64,
                 O_SFV = O_SFK + (size_t)MS * 512, O_SFLF = O_SFV + (size_t)MS * 512, O_SDK = O_SFLF + (size_t)MS * 8, O_SDV = O_SDK + (size_t)MS * 128,
                 O_SIK = O_SDV + (size_t)MS * 128, O_END = O_SIK + (size_t)MS * 64;
static_assert(O_END == 156321792, "d_out size");

constexpr size_t al256(size_t x) { return (x + 255) & ~(size_t)255; }
constexpr size_t WS_WIN = 0, WS_WO = WS_WIN + al256((size_t)NIN * DM * 2), WS_WGU = WS_WO + al256((size_t)DM * DM * 2), WS_WD = WS_WGU + al256((size_t)NGU * DM * 2),
                 WS_ROPE = WS_WD + al256((size_t)DM * DFF * 2), WS_XB = WS_ROPE + al256((size_t)NKEY_S * 16 * 4), WS_AO = WS_XB  ,
                 WS_FQ = WS_XB + al256((size_t)MT * DM * 2), WS_FKP = WS_FQ + al256((size_t)MT * 512 * 2), WS_FVP = WS_FKP + al256((size_t)MP * 512 * 2),
                 WS_FKA = WS_FVP + al256((size_t)MP * 512 * 2), WS_FVA = WS_FKA + al256((size_t)DB * KVS * 512 * 2), WS_DQ = WS_FVA + al256((size_t)DB * KVS * 512 * 2),
                 WS_DKP = WS_DQ + al256((size_t)MT * 512 * 2), WS_DVP = WS_DKP + al256((size_t)MP * 128 * 2), WS_DKA = WS_DVP + al256((size_t)MP * 128 * 2),
                 WS_DVA = WS_DKA + al256((size_t)DB * KVS * 128 * 2), WS_IQ = WS_DVA + al256((size_t)DB * KVS * 128 * 2), WS_IKP = WS_IQ + al256((size_t)MT * 256 * 2),
                 WS_IKA = WS_IKP + al256((size_t)MP * 64 * 2), WS_IW = WS_IKA + al256((size_t)DB * KVS * 64 * 2), WS_BIASP = WS_IW + al256((size_t)MT * 4 * 4),
                 WS_BIASS = WS_BIASP + al256((size_t)NBATCH * 8 * SEQ * 4), WS_NORM = WS_BIASS + al256((size_t)DB * 8 * KVS * 4), WS_SCR = WS_NORM + 4096  ,
                 WS_MASK = WS_SCR + al256((size_t)256 * 64 * SCR_LD * 4), WS_END1 = WS_MASK + al256((size_t)MT * MW * 8);
constexpr size_t WS_Z = WS_FQ, WS_HB = WS_Z + al256((size_t)MT * DM * 4), WS_ACT = WS_HB + al256((size_t)MT * DM * 2), WS_ST1 = WS_ACT + al256((size_t)MT * DFF * 2),
                 WS_ST2 = WS_ST1 + al256((size_t)MT * 16 * 8), WS_RS1 = WS_ST2 + al256((size_t)MT * 16 * 8), WS_END2 = WS_RS1 + al256((size_t)MT * 8);
constexpr size_t WS_Z2B = WS_XB;
constexpr size_t WS_NEED = WS_END1 > WS_END2 ? WS_END1 : WS_END2;
static_assert(WS_NEED <= (size_t)1073741824, "workspace map exceeds 4x the largest tensor");

struct KP {
    const float *xp, *xs, *cfk, *cfv, *cflf, *cdk, *cdv, *cik, *w_in, *b_forget, *w_out, *ln1g, *ln1b, *w_gate, *w_up, *w_down, *ln2g, *ln2b;
    float* out; unsigned char* ws;
};
namespace pg8 {
#define PG8_LAS __attribute__((address_space(3)))
typedef unsigned short bf16_t;
typedef short bf16x8 __attribute__((ext_vector_type(8)));
typedef float f32x4 __attribute__((ext_vector_type(4)));
typedef unsigned u32x4 __attribute__((ext_vector_type(4)));
constexpr int BM = 256, BK = 64, HALF = 128, HTB = HALF * BK * 2  , STAGE_BYTES = 8 * HTB, NXCD = 8, WGM = 8;

__host__ __device__ __forceinline__ int lds_byte(int r, int c) { const int st = (r >> 4) * 2 + (c >> 5), rr = r & 15, cc = c & 31, ob = rr * 64 + cc * 2; return st * 1024 + (ob ^ (((ob >> 9) & 1) << 5)); }
__host__ __device__ __forceinline__ void stage_rc(int b, int& R, int& C) { const int st = b / 1024, sb = b % 1024, swz = sb ^ (((sb >> 9) & 1) << 5); R = (st >> 1) * 16 + swz / 64; C = (st & 1) * 32 + (swz % 64) / 2; }
__host__ __device__ __forceinline__ int perm32(int rho) { const int n = rho >> 4, i = rho & 15; return 8 * (i >> 2) + 4 * n + (i & 3); }

struct Unit { int pm, pn; };
struct Gemm { const bf16_t* A; const bf16_t* Bt; int M, N, K; };

struct StaticOrder {
    int nM, nN, nwg, G, c;
    __host__ __device__ void init(int M, int N, int G_, int c_) { nM = M / BM; nN = N / BM; nwg = nM * nN; G = G_; c = c_; }
    __host__ __device__ bool next(int i, Unit& u) const {
        const long L = (long)i * G + c; if (L >= nwg) return false;
        int wgid = (int)L; { const int q = nwg / NXCD, r = nwg % NXCD, xcd = wgid % NXCD, off = wgid / NXCD; wgid = (xcd < r ? xcd * (q + 1) : r * (q + 1) + (xcd - r) * q) + off; }
        const int nig = WGM * nN, gid = wgid / nig, fm = gid * WGM, gsz = (nM - fm) < WGM ? (nM - fm) : WGM;
        u.pm = fm + ((wgid % nig) % gsz); u.pn = (wgid % nig) / gsz; return true;
    }
    __device__ __forceinline__ void a_ready(const Unit&) const {}
    __device__ __forceinline__ void done(const Unit&) const {}
};

__device__ __forceinline__ unsigned cvt_pk_bf16(float lo, float hi) { unsigned r; asm volatile("v_cvt_pk_bf16_f32 %0, %1, %2" : "=v"(r) : "v"(lo), "v"(hi)); return r; }
typedef float f32x2 __attribute__((ext_vector_type(2)));
__device__ __forceinline__ void st_bf16x8(bf16_t* p, f32x4 v0, f32x4 v1) { u32x4 w; w.x = cvt_pk_bf16(v0[0], v0[1]); w.y = cvt_pk_bf16(v0[2], v0[3]); w.z = cvt_pk_bf16(v1[0], v1[1]); w.w = cvt_pk_bf16(v1[2], v1[3]); *(u32x4*)p = w; }
__device__ __forceinline__ void st_f32x8(float* p, f32x4 v0, f32x4 v1) { *(f32x4*)p = v0; *(f32x4*)(p + 4) = v1; }
__device__ __forceinline__ void rope8(f32x4& v0, f32x4& v1, const float* tab, int fq) {
    f32x4 o0, o1; const bool oddrow = (fq & 1) != 0;
#pragma unroll
    for (int j = 0; j < 4; ++j) {
        { const unsigned u = __float_as_uint(v0[j]); auto rr = __builtin_amdgcn_permlane16_swap(u, u, false, false); o0[j] = __uint_as_float(oddrow ? rr[0] : rr[1]); }
        { const unsigned u = __float_as_uint(v1[j]); auto rr = __builtin_amdgcn_permlane16_swap(u, u, false, false); o1[j] = __uint_as_float(oddrow ? rr[0] : rr[1]); }
    }
    if (fq < 2) {
        const f32x4 c0 = *(const f32x4*)tab, c1 = *(const f32x4*)(tab + 4), s0 = *(const f32x4*)(tab + 8), s1 = *(const f32x4*)(tab + 12);
        if (fq == 0) { v0 = v0 * c0 - o0 * s0; v1 = v1 * c1 - o1 * s1; } else { v0 = v0 * c0 + o0 * s0; v1 = v1 * c1 + o1 * s1; }
    }
}
struct EpiIn {
    static constexpr bool PERM = true, AFTER_DRAIN = false;
    float* out; unsigned char* ws; const float* bforget;
    __device__ __forceinline__ void operator()(const f32x4 (&acc)[2][2][4][2], const Unit& u, int wr, int wc, int fr, int fq) const {
        const int pn = u.pn; const bool samp = (u.pm == MP / 256);
        const float* rope = (const float*)(ws + WS_ROPE);
#pragma unroll
        for (int ai = 0; ai < 2; ++ai)
#pragma unroll
            for (int m = 0; m < 4; ++m) {
                const int row = u.pm * 256 + ai * 128 + wr * 64 + m * 16 + fr;
                const int r2 = row - MP, sb = r2 >> 5, ss = r2 & 31;
                const int pos = samp ? (4096 + ss) : (row & 4095);
                const size_t arow = samp ? ((size_t)sb * KVS + 4096 + ss) : (size_t)row;
                const float* tab = rope + pos * 16;
#pragma unroll
                for (int bj = 0; bj < 2; ++bj) {
                    f32x4 v0 = acc[ai][bj][m][0], v1 = acc[ai][bj][m][1];
                    const int cit = bj * 128 + wc * 32 + fq * 8;
                    if (pn < 2) { st_bf16x8((bf16_t*)(ws + WS_FQ) + (size_t)row * 512 + pn * 256 + cit, v0 * C2, v1 * C2); }
                    else if (pn < 6) {
                        const bool isv = pn >= 4; const int col = (pn & 1) * 256 + cit;
                        float* fo = samp ? out + (isv ? O_SFV : O_SFK) + (size_t)r2 * 512 : out + (isv ? O_PFV : O_PFK) + (size_t)row * 512;
                        bf16_t* bo = (bf16_t*)(ws + (samp ? (isv ? WS_FVA : WS_FKA) : (isv ? WS_FVP : WS_FKP))) + arow * 512;
                        st_f32x8(fo + col, v0, v1); st_bf16x8(bo + col, v0, v1);
                    } else if (pn < 8) {
                        if ((wc & 1) == 0) rope8(v0, v1, tab, fq);
                        st_bf16x8((bf16_t*)(ws + WS_DQ) + (size_t)row * 512 + (pn - 6) * 256 + cit, v0 * C2, v1 * C2);
                    } else if (pn == 8) {
                        const bool isv = (bj == 1); const int col = cit - bj * 128;
                        if (!isv) { if ((wc & 1) == 0) rope8(v0, v1, tab, fq); }
                        float* fo = samp ? out + (isv ? O_SDV : O_SDK) + (size_t)r2 * 128 : out + (isv ? O_PDV : O_PDK) + (size_t)row * 128;
                        bf16_t* bo = (bf16_t*)(ws + (samp ? (isv ? WS_DVA : WS_DKA) : (isv ? WS_DVP : WS_DKP))) + arow * 128;
                        st_f32x8(fo + col, v0, v1); st_bf16x8(bo + col, v0, v1);
                    } else if (pn == 9) {
                        if ((wc & 1) == 0) rope8(v0, v1, tab, fq);
                        st_bf16x8((bf16_t*)(ws + WS_IQ) + (size_t)row * 256 + cit, v0, v1);
                    } else if (bj == 0) {
                        if (wc < 2) {
                            if (wc == 0) rope8(v0, v1, tab, fq);
                            float* fo = samp ? out + O_SIK + (size_t)r2 * 64 : out + O_PIK + (size_t)row * 64;
                            bf16_t* bo = (bf16_t*)(ws + (samp ? WS_IKA : WS_IKP)) + arow * 64;
                            st_f32x8(fo + cit, v0, v1); st_bf16x8(bo + cit, v0, v1);
                        } else if (wc == 2) {
                            if (fq == 0) {
                                const f32x4 b0 = *(const f32x4*)bforget, b1 = *(const f32x4*)(bforget + 4);
                                f32x4 z0 = v0 + b0, z1 = v1 + b1, l0, l1;
#pragma unroll
                                for (int j = 0; j < 4; ++j) { l0[j] = fminf(z0[j], 0.f) - log1pf(__expf(-fabsf(z0[j]))); l1[j] = fminf(z1[j], 0.f) - log1pf(__expf(-fabsf(z1[j]))); }
                                float* fo = samp ? out + O_SFLF + (size_t)r2 * 8 : out + O_PFLF + (size_t)row * 8;
                                st_f32x8(fo, l0, l1);
                            } else if (fq == 1) { *(f32x4*)((float*)(ws + WS_IW) + (size_t)row * 4) = v0; }
                        }
                    }
                }
            }
    }
};
__device__ __forceinline__ float add_xor16(float x) { const unsigned u = __builtin_bit_cast(unsigned, x); auto rr = __builtin_amdgcn_permlane16_swap(u, u, false, false); return __builtin_bit_cast(float, (unsigned)rr[0]) + __builtin_bit_cast(float, (unsigned)rr[1]); }
__device__ __forceinline__ float add_xor32(float x) { const unsigned u = __builtin_bit_cast(unsigned, x); auto rr = __builtin_amdgcn_permlane32_swap(u, u, false, false); return __builtin_bit_cast(float, (unsigned)rr[0]) + __builtin_bit_cast(float, (unsigned)rr[1]); }
struct EpiZ {
    static constexpr bool PERM = true, AFTER_DRAIN = false;
    const float* base_p; const float* base_s; float* zout; float* stats;
    __device__ __forceinline__ void operator()(const f32x4 (&acc)[2][2][4][2], const Unit& u, int wr, int wc, int fr, int fq) const {
        const bool samp = (u.pm == MP / 256);
#pragma unroll
        for (int ai = 0; ai < 2; ++ai)
#pragma unroll
            for (int m = 0; m < 4; ++m) {
                const int row = u.pm * 256 + ai * 128 + wr * 64 + m * 16 + fr;
                const float* bp = samp ? base_s + (size_t)(row - MP) * DM : base_p + (size_t)row * DM;
                float sm = 0.f, sq = 0.f;
#pragma unroll
                for (int bj = 0; bj < 2; ++bj) {
                    const int col = u.pn * 256 + bj * 128 + wc * 32 + fq * 8;
                    const f32x4 x0 = *(const f32x4*)(bp + col), x1 = *(const f32x4*)(bp + col + 4);
                    const f32x4 z0 = x0 * ALPHA + acc[ai][bj][m][0], z1 = x1 * ALPHA + acc[ai][bj][m][1];
                    st_f32x8(zout + (size_t)row * DM + col, z0, z1);
                    sm += (z0[0] + z0[1]) + (z0[2] + z0[3]) + (z1[0] + z1[1]) + (z1[2] + z1[3]);
                    sq += (z0[0] * z0[0] + z0[1] * z0[1]) + (z0[2] * z0[2] + z0[3] * z0[3]) + (z1[0] * z1[0] + z1[1] * z1[1]) + (z1[2] * z1[2] + z1[3] * z1[3]);
                }
                sm = add_xor32(add_xor16(sm)); sq = add_xor32(add_xor16(sq));
                if (fq == 0) { float* sp = stats + ((size_t)row * 16 + u.pn * 4 + wc) * 2; sp[0] = sm; sp[1] = sq; }
            }
    }
};
struct EpiZ2 {
    static constexpr bool PERM = true, AFTER_DRAIN = false;
    const float* z; const float* rowstat; const float* g1; const float* b1; bf16_t* z2b; float* stats;
    __device__ __forceinline__ void operator()(const f32x4 (&acc)[2][2][4][2], const Unit& u, int wr, int wc, int fr, int fq) const {
#pragma unroll
        for (int ai = 0; ai < 2; ++ai)
#pragma unroll
            for (int m = 0; m < 4; ++m) {
                const int row = u.pm * 256 + ai * 128 + wr * 64 + m * 16 + fr;
                const float mean = rowstat[2 * (size_t)row], rstd = rowstat[2 * (size_t)row + 1];
                float sm = 0.f, sq = 0.f;
#pragma unroll
                for (int bj = 0; bj < 2; ++bj) {
                    const int col = u.pn * 256 + bj * 128 + wc * 32 + fq * 8;
                    const float* zp = z + (size_t)row * DM + col;
                    const f32x4 x0 = *(const f32x4*)zp, x1 = *(const f32x4*)(zp + 4);
                    const f32x4 ga = *(const f32x4*)(g1 + col), gb = *(const f32x4*)(g1 + col + 4), ba = *(const f32x4*)(b1 + col), bb = *(const f32x4*)(b1 + col + 4);
                    const f32x4 h0 = (x0 - mean) * rstd * ga + ba, h1 = (x1 - mean) * rstd * gb + bb;
                    const f32x4 z0 = h0 * ALPHA + acc[ai][bj][m][0], z1 = h1 * ALPHA + acc[ai][bj][m][1];
                    st_bf16x8(z2b + (size_t)row * DM + col, z0, z1);
                    sm += (z0[0] + z0[1]) + (z0[2] + z0[3]) + (z1[0] + z1[1]) + (z1[2] + z1[3]);
                    sq += (z0[0] * z0[0] + z0[1] * z0[1]) + (z0[2] * z0[2] + z0[3] * z0[3]) + (z1[0] * z1[0] + z1[1] * z1[1]) + (z1[2] * z1[2] + z1[3] * z1[3]);
                }
                sm = add_xor32(add_xor16(sm)); sq = add_xor32(add_xor16(sq));
                if (fq == 0) { float* sp = stats + ((size_t)row * 16 + u.pn * 4 + wc) * 2; sp[0] = sm; sp[1] = sq; }
            }
    }
};
struct EpiAct {
    static constexpr bool PERM = true, AFTER_DRAIN = false;
    bf16_t* act;
    __device__ __forceinline__ void operator()(const f32x4 (&acc)[2][2][4][2], const Unit& u, int wr, int wc, int fr, int fq) const {
#pragma unroll
        for (int ai = 0; ai < 2; ++ai)
#pragma unroll
            for (int m = 0; m < 4; ++m) {
                const int row = u.pm * 256 + ai * 128 + wr * 64 + m * 16 + fr;
                f32x4 a0, a1;
#pragma unroll
                for (int j = 0; j < 4; ++j) {
                    const float g0 = acc[ai][0][m][0][j], g1 = acc[ai][0][m][1][j];
                    a0[j] = g0 * __builtin_amdgcn_rcpf(1.f + __expf(-g0)) * acc[ai][1][m][0][j];
                    a1[j] = g1 * __builtin_amdgcn_rcpf(1.f + __expf(-g1)) * acc[ai][1][m][1][j];
                }
                st_bf16x8(act + (size_t)row * DFF + u.pn * 128 + wc * 32 + fq * 8, a0, a1);
            }
    }
};
template <class Epi, class Sched, bool ALIGN_EPI = false, bool SP2 = false>
__device__ __forceinline__ void gemm_phase(PG8_LAS unsigned char* lds, const Gemm g, const Sched& S, const Epi& E) {
    int tid_ = threadIdx.x; asm volatile("" : "+v"(tid_));
    const int tid = tid_, wid = __builtin_amdgcn_readfirstlane(tid >> 6), lane = tid & 63, wr = wid >> 2, wc = wid & 3, fr = lane & 15, fq = lane >> 4;
    const int K = g.K, nt = K / BK;
    unsigned voffA[2], voffB[2];
#pragma unroll
    for (int i = 0; i < 2; ++i) { int R, C; stage_rc(tid * 16 + i * 8192, R, C); const int Rb = Epi::PERM ? ((R & ~31) + perm32(R & 31)) : R;
        voffA[i] = (unsigned)(R * K + C) * 2u; voffB[i] = (unsigned)(Rb * K + C) * 2u; }
    const size_t kstep = (size_t)(BK * 2);
    const size_t hstep = (size_t)HALF * K * 2;
    const size_t tstep = 2 * hstep;
    const unsigned ldsw = (unsigned)wid * 1024u;
    const int aoff = lds_byte(wr * 64 + fr, fq * 8), boff = lds_byte(wc * 32 + fr, fq * 8);
#define PG8_SA(b, h) (((b) * 2 + (h)) * HTB)
#define PG8_SB(b, h) ((4 + (b) * 2 + (h)) * HTB)
#define PG8_STAGE(bufoff, gbase, voff) do { _Pragma("unroll") for (int _i = 0; _i < 2; ++_i) \
        __builtin_amdgcn_global_load_lds((const unsigned*)((const char*)(gbase) + (voff)[_i]), (PG8_LAS unsigned*)(lds + (bufoff) + ldsw + _i * 8192), 16, 0, 0); } while (0)
#define PG8_LDA(dst, b, h) do { _Pragma("unroll") for (int m = 0; m < 4; ++m) _Pragma("unroll") for (int k = 0; k < 2; ++k) dst[m][k] = *(const PG8_LAS bf16x8*)(lds + PG8_SA(b, h) + aoff + m * 2048 + k * 1024); } while (0)
#define PG8_LDB(dst, b, h) do { _Pragma("unroll") for (int n = 0; n < 2; ++n) _Pragma("unroll") for (int k = 0; k < 2; ++k) dst[n][k] = *(const PG8_LAS bf16x8*)(lds + PG8_SB(b, h) + boff + n * 2048 + k * 1024); } while (0)
#define PG8_MMA(ai, bj, At, Bt) do { __builtin_amdgcn_s_setprio(1); _Pragma("unroll") for (int m = 0; m < 4; ++m) _Pragma("unroll") for (int n = 0; n < 2; ++n) _Pragma("unroll") for (int k = 0; k < 2; ++k) \
        acc[ai][bj][m][n] = __builtin_amdgcn_mfma_f32_16x16x32_bf16(Bt[n][k], At[m][k], acc[ai][bj][m][n], 0, 0, 0); __builtin_amdgcn_s_setprio(0); } while (0)
#define PG8_WAIT_V(n) asm volatile("s_waitcnt vmcnt(" #n ")" ::: "memory")
#define PG8_WAIT_L(n) asm volatile("s_waitcnt lgkmcnt(" #n ")" ::: "memory")
#define PG8_BAR __builtin_amdgcn_s_barrier()
#define PG8_SCHED __builtin_amdgcn_sched_barrier(0)
    Unit cur, nxt; int ui = 0;
    if (!S.next(0, cur)) return;
    f32x4 acc[2][2][4][2];
#pragma unroll
    for (int a = 0; a < 2; ++a)
#pragma unroll
        for (int b = 0; b < 2; ++b)
#pragma unroll
            for (int m = 0; m < 4; ++m)
#pragma unroll
                for (int n = 0; n < 2; ++n) acc[a][b][m][n] = (f32x4){0.f, 0.f, 0.f, 0.f};
    bf16x8 At[4][2], B0[2][2], B1[2][2];
    const char* cA = (const char*)g.A + (size_t)cur.pm * tstep; const char* cB = (const char*)g.Bt + (size_t)cur.pn * tstep;
    S.a_ready(cur);
    if constexpr (SP2) {
        PG8_STAGE(PG8_SB(0, 0), cB, voffB); PG8_STAGE(PG8_SB(0, 1), cB + hstep, voffB); PG8_STAGE(PG8_SA(0, 0), cA, voffA); PG8_STAGE(PG8_SA(0, 1), cA + hstep, voffA);
        if (wr == 1) PG8_BAR;
        PG8_WAIT_V(2); PG8_BAR;
        PG8_STAGE(PG8_SB(1, 0), cB + kstep, voffB); PG8_STAGE(PG8_SA(1, 0), cA + kstep, voffA); PG8_STAGE(PG8_SB(1, 1), cB + hstep + kstep, voffB);
        PG8_WAIT_V(6); PG8_BAR;
    } else {
        PG8_STAGE(PG8_SB(0, 0), cB, voffB); PG8_STAGE(PG8_SA(0, 0), cA, voffA); PG8_STAGE(PG8_SB(0, 1), cB + hstep, voffB); PG8_STAGE(PG8_SA(0, 1), cA + hstep, voffA);
        if (wr == 1) PG8_BAR;
        PG8_WAIT_V(4); PG8_BAR;
        PG8_STAGE(PG8_SB(1, 0), cB + kstep, voffB); PG8_STAGE(PG8_SA(1, 0), cA + kstep, voffA); PG8_STAGE(PG8_SB(1, 1), cB + hstep + kstep, voffB);
        PG8_WAIT_V(6); PG8_BAR;
    }
    for (;;) {
        const bool has_next = S.next(ui + 1, nxt);
        const char* nA = has_next ? (const char*)g.A + (size_t)nxt.pm * tstep : cA; const char* nB = has_next ? (const char*)g.Bt + (size_t)nxt.pn * tstep : cB;
        for (int t = 0; t < nt; t += 2) {
            const bool last = (t == nt - 2);
            const char* a1 = cA + (size_t)(t + 1) * kstep;
            const char* a2 = last ? nA : cA + (size_t)(t + 2) * kstep; const char* b2 = last ? nB : cB + (size_t)(t + 2) * kstep;
            const char* a3 = a2 + kstep; const char* b3 = b2 + kstep;
            if (last && has_next) S.a_ready(nxt);
            if constexpr (SP2) {
            PG8_LDB(B0, 0, 0); PG8_LDB(B1, 0, 1); PG8_SCHED; PG8_LDA(At, 0, 0); PG8_STAGE(PG8_SA(1, 1), a1 + hstep, voffA);
            PG8_WAIT_V(8); PG8_WAIT_L(0); PG8_BAR; PG8_MMA(0, 0, At, B0); PG8_MMA(0, 1, At, B1); PG8_BAR; PG8_SCHED;
            PG8_LDA(At, 0, 1); PG8_STAGE(PG8_SB(0, 0), b2, voffB); PG8_STAGE(PG8_SB(0, 1), b2 + hstep, voffB); PG8_STAGE(PG8_SA(0, 0), a2, voffA);
            PG8_WAIT_V(8); PG8_WAIT_L(0); PG8_BAR; PG8_MMA(1, 0, At, B0); PG8_MMA(1, 1, At, B1); PG8_BAR; PG8_SCHED;
            PG8_LDB(B0, 1, 0); PG8_LDB(B1, 1, 1); PG8_SCHED; PG8_LDA(At, 1, 0); PG8_STAGE(PG8_SA(0, 1), a2 + hstep, voffA);
            PG8_WAIT_V(8); PG8_WAIT_L(0); PG8_BAR; PG8_MMA(0, 0, At, B0); PG8_MMA(0, 1, At, B1); PG8_BAR; PG8_SCHED;
            PG8_LDA(At, 1, 1); PG8_STAGE(PG8_SB(1, 0), b3, voffB); PG8_STAGE(PG8_SB(1, 1), b3 + hstep, voffB); PG8_STAGE(PG8_SA(1, 0), a3, voffA);
            PG8_WAIT_V(8); PG8_WAIT_L(0); PG8_BAR; PG8_MMA(1, 0, At, B0); PG8_MMA(1, 1, At, B1); PG8_BAR; PG8_SCHED;
            } else {
            PG8_LDB(B0, 0, 0); PG8_SCHED; PG8_LDA(At, 0, 0); PG8_STAGE(PG8_SA(1, 1), a1 + hstep, voffA);
            PG8_WAIT_L(8); PG8_BAR; PG8_WAIT_L(0); PG8_MMA(0, 0, At, B0); PG8_BAR; PG8_SCHED;
            PG8_LDB(B1, 0, 1); PG8_STAGE(PG8_SB(0, 0), b2, voffB);
            PG8_BAR; PG8_WAIT_L(0); PG8_MMA(0, 1, At, B1); PG8_BAR;
            PG8_LDA(At, 0, 1); PG8_STAGE(PG8_SA(0, 0), a2, voffA);
            PG8_BAR; PG8_WAIT_L(0); PG8_MMA(1, 0, At, B0); PG8_BAR; PG8_SCHED;
            PG8_STAGE(PG8_SB(0, 1), b2 + hstep, voffB);
            PG8_WAIT_V(6); PG8_BAR; PG8_MMA(1, 1, At, B1); PG8_BAR;
            PG8_LDB(B0, 1, 0); PG8_SCHED; PG8_LDA(At, 1, 0); PG8_STAGE(PG8_SA(0, 1), a2 + hstep, voffA);
            PG8_WAIT_L(8); PG8_BAR; PG8_WAIT_L(0); PG8_MMA(0, 0, At, B0); PG8_BAR; PG8_SCHED;
            PG8_LDB(B1, 1, 1); PG8_STAGE(PG8_SB(1, 0), b3, voffB);
            PG8_BAR; PG8_WAIT_L(0); PG8_MMA(0, 1, At, B1); PG8_BAR;
            PG8_LDA(At, 1, 1); PG8_STAGE(PG8_SA(1, 0), a3, voffA);
            PG8_BAR; PG8_WAIT_L(0); PG8_MMA(1, 0, At, B0); PG8_BAR; PG8_SCHED;
            PG8_STAGE(PG8_SB(1, 1), b3 + hstep, voffB);
            PG8_WAIT_V(6); PG8_BAR; PG8_MMA(1, 1, At, B1); PG8_BAR;
            }
        }
        if constexpr (ALIGN_EPI) { if (wr == 0) PG8_BAR; }
        if constexpr (!Epi::AFTER_DRAIN) { E(acc, cur, wr, wc, fr, fq); S.done(cur); }
        if (!has_next) break;
#pragma unroll
        for (int a = 0; a < 2; ++a)
#pragma unroll
            for (int b = 0; b < 2; ++b)
#pragma unroll
                for (int m = 0; m < 4; ++m)
#pragma unroll
                    for (int n = 0; n < 2; ++n) acc[a][b][m][n] = (f32x4){0.f, 0.f, 0.f, 0.f};
        cur = nxt; cA = nA; cB = nB; ++ui;
        if constexpr (ALIGN_EPI) { if (wr == 1) PG8_BAR; }
    }
    PG8_WAIT_V(0);
    if constexpr (!ALIGN_EPI) { if (wr == 0) PG8_BAR; }
    PG8_BAR;
    if constexpr (Epi::AFTER_DRAIN) { E.fused(acc, cur, wr, wc, fr, fq, lds, wid, lane); S.done(cur); }
#undef PG8_SA
#undef PG8_SB
#undef PG8_STAGE
#undef PG8_LDA
#undef PG8_LDB
#undef PG8_MMA
#undef PG8_WAIT_V
#undef PG8_WAIT_L
#undef PG8_BAR
#undef PG8_SCHED
}
}
#ifndef REP_SEL
#define REP_SEL 1
#endif
#define LDS_WAIT() asm volatile("s_waitcnt lgkmcnt(0)" ::: "memory")
__device__ __forceinline__ unsigned pk2(float lo, float hi) { return pg8::cvt_pk_bf16(lo, hi); }
__device__ __forceinline__ float wave_sum(float v) {
#pragma unroll
    for (int o = 1; o < 64; o <<= 1) v += __shfl_xor(v, o);
    return v;
}
template <int CTRL> __device__ __forceinline__ int dpp_mov(int x) { return __builtin_amdgcn_update_dpp(x, x, CTRL, 0xF, 0xF, false); }
__device__ __forceinline__ float row_sum16(float x) {
    x += __int_as_float(dpp_mov<0xB1>(__float_as_int(x))); x += __int_as_float(dpp_mov<0x4E>(__float_as_int(x)));
    x += __int_as_float(dpp_mov<0x124>(__float_as_int(x))); x += __int_as_float(dpp_mov<0x128>(__float_as_int(x))); return x;
}
__device__ __forceinline__ unsigned row_max16(unsigned x) {
    unsigned y;
    y = (unsigned)dpp_mov<0xB1>((int)x); x = x > y ? x : y; y = (unsigned)dpp_mov<0x4E>((int)x); x = x > y ? x : y;
    y = (unsigned)dpp_mov<0x124>((int)x); x = x > y ? x : y; y = (unsigned)dpp_mov<0x128>((int)x); x = x > y ? x : y; return x;
}
struct Ctx { int tid, lane, wid, gw, ngw; LAS unsigned char* lds; };

__device__ __forceinline__ void transpose_item(const float* colp, int ldw, int k0, bf16* WT, int K, int dst_row0, LAS float* scr, int lane) {
#pragma unroll 8
    for (int i = 0; i < 32; ++i) { const int kk = 2 * i + (lane >> 5); scr[kk * 33 + (lane & 31)] = colp ? colp[(size_t)(k0 + kk) * ldw] : 0.f; }
    LDS_WAIT(); asm volatile("" ::: "memory");
    const int c = lane & 7;
#pragma unroll
    for (int j = 0; j < 4; ++j) { const int n = (lane >> 3) + 8 * j; const LAS float* s = scr + (8 * c) * 33 + n;
        u32x4 o; o.x = pk2(s[0 * 33], s[1 * 33]); o.y = pk2(s[2 * 33], s[3 * 33]); o.z = pk2(s[4 * 33], s[5 * 33]); o.w = pk2(s[6 * 33], s[7 * 33]);
        *(u32x4*)(WT + (size_t)(dst_row0 + n) * K + k0 + 8 * c) = o; }
    LDS_WAIT(); asm volatile("" ::: "memory");
}
__device__ __forceinline__ int win_src_col(int d) {
    if (d < 1536) return d;
    if (d < 2624) return d + 8;
    if (d < 2632) return 1536 + (d - 2624);
    if (d < 2636) return d;
    return -1;
}
__device__ __forceinline__ void cvt_copy(const Ctx& c, const float* src, bf16* dst, size_t n) {
    const size_t stride = (size_t)c.ngw * 64 * 8;
    for (size_t i = ((size_t)c.gw * 64 + c.lane) * 8; i < n; i += 4 * stride) {
        f32x4 a[4], b[4];
#pragma unroll
        for (int u = 0; u < 4; ++u) { const size_t j = i + u * stride; const size_t jc = j < n ? j : i; a[u] = *(const f32x4*)(src + jc); b[u] = *(const f32x4*)(src + jc + 4); }
#pragma unroll
        for (int u = 0; u < 4; ++u) { const size_t j = i + u * stride; if (j < n) {
            u32x4 o; o.x = pk2(a[u][0], a[u][1]); o.y = pk2(a[u][2], a[u][3]); o.z = pk2(b[u][0], b[u][1]); o.w = pk2(b[u][2], b[u][3]);
            *(u32x4*)(dst + j) = o; } }
    }
}
__device__ __forceinline__ void p0_prologue(const KP& p, const Ctx& c) {
    LAS float* scr = (LAS float*)(c.lds + c.wid * 16384);
    unsigned char* ws = p.ws;
    constexpr int I_IN = (NIN / 32) * 16, I_O = 32 * 16, I_GU = (NGU / 32) * 16, I_D = 32 * (DFF / 64);
    for (int it = c.gw; it < I_IN + I_O + I_GU + I_D; it += c.ngw) {
        int r = it; const int ln = c.lane & 31;
        if (r < I_IN) { const int nb = r >> 4, kb = r & 15; const int sc = win_src_col(32 * nb + ln);
            transpose_item(sc >= 0 ? p.w_in + sc : nullptr, 2636, 64 * kb, (bf16*)(ws + WS_WIN), DM, 32 * nb, scr, c.lane); continue; } r -= I_IN;
        if (r < I_O) { const int nb = r >> 4, kb = r & 15; transpose_item(p.w_out + 32 * nb + ln, DM, 64 * kb, (bf16*)(ws + WS_WO), DM, 32 * nb, scr, c.lane); continue; } r -= I_O;
        if (r < I_GU) { const int nb = r >> 4, kb = r & 15; const int d = 32 * nb + ln, pn = d >> 8, rr = d & 255;
            transpose_item(rr < 128 ? p.w_gate + 128 * pn + rr : p.w_up + 128 * pn + rr - 128, DFF, 64 * kb, (bf16*)(ws + WS_WGU), DM, 32 * nb, scr, c.lane); continue; } r -= I_GU;
        { const int nb = r / (DFF / 64), kb = r % (DFF / 64); transpose_item(p.w_down + 32 * nb + ln, DM, 64 * kb, (bf16*)(ws + WS_WD), DFF, 32 * nb, scr, c.lane); }
    }
    cvt_copy(c, p.xp, (bf16*)(ws + WS_XB), (size_t)MP * DM);
    cvt_copy(c, p.xs, (bf16*)(ws + WS_XB) + (size_t)MP * DM, (size_t)MS * DM);
    for (int b = 0; b < DB; ++b) {
        cvt_copy(c, p.cik + (size_t)b * 4096 * 64, (bf16*)(ws + WS_IKA) + (size_t)b * KVS * 64, (size_t)4096 * 64);
    }
    for (int g = c.gw * 64 + c.lane; g < DB * 32 * 160; g += c.ngw * 64) {
        const int b = g / (32 * 160), rr = (g / 160) & 31, pc = g % 160; const size_t rowi = (size_t)b * KVS + NKEY_S + rr; const u32x4 z = (u32x4){0u, 0u, 0u, 0u};
        if (pc < 64) *(u32x4*)((bf16*)(ws + WS_FKA) + rowi * 512 + pc * 8) = z;
        else if (pc < 128) *(u32x4*)((bf16*)(ws + WS_FVA) + rowi * 512 + (pc - 64) * 8) = z;
        else if (pc < 144) *(u32x4*)((bf16*)(ws + WS_DKA) + rowi * 128 + (pc - 128) * 8) = z;
        else *(u32x4*)((bf16*)(ws + WS_DVA) + rowi * 128 + (pc - 144) * 8) = z;
    }
    if (c.gw == 0) { for (int i = c.lane; i < 1024; i += 64) ((unsigned*)(ws + WS_NORM))[i] = 0u; }
    for (int g = c.gw * 64 + c.lane; g < NKEY_S * 8; g += c.ngw * 64) {
        const int pos = g >> 3, i = g & 7;
        const float invf = i == 0 ? 1.0f : i == 1 ? 0.1939227432012558f : i == 2 ? 0.03760603070259094f : i == 3 ? 0.007292664609849453f : i == 4 ? 0.0014142135623842478f
                         : i == 5 ? 0.00027424818836152554f : i == 6 ? 5.318296098266728e-05f : 1.0313386155758053e-05f;
        const float ang = (float)pos * invf;
        double t = (double)ang * 0.15915494309189535; t -= rint(t);
        const double q = rint(t * 4.0); const double r = (t - q * 0.25) * 6.283185307179586; const int qi = ((int)q) & 3;
        const double r2 = r * r;
        const double sn = r * (1.0 + r2 * (-1.0 / 6 + r2 * (1.0 / 120 + r2 * (-1.0 / 5040 + r2 * (1.0 / 362880 + r2 * (-1.0 / 39916800 + r2 * (1.0 / 6227020800.0)))))));
        const double cs = 1.0 + r2 * (-0.5 + r2 * (1.0 / 24 + r2 * (-1.0 / 720 + r2 * (1.0 / 40320 + r2 * (-1.0 / 3628800 + r2 * (1.0 / 479001600.0 + r2 * (-1.0 / 87178291200.0)))))));
        const double cc = qi == 0 ? cs : qi == 1 ? -sn : qi == 2 ? -cs : sn;
        const double ssn = qi == 0 ? sn : qi == 1 ? cs : qi == 2 ? -sn : -cs;
        float* tab = (float*)(ws + WS_ROPE) + pos * 16;
        tab[i] = (float)cc; tab[8 + i] = (float)ssn;
    }
}

__device__ __forceinline__ void cumsum_item(const KP& p, int item, int lane) {
    const bool samp = item >= 16; const int b = samp ? item - 16 : item; const int n = samp ? NKEY_S : SEQ;
    const float* src0 = samp ? p.cflf + (size_t)b * 4096 * 8 : p.out + O_PFLF + (size_t)b * 4096 * 8;
    const float* src1 = p.out + O_SFLF + (size_t)b * 32 * 8;
    float* dst = samp ? (float*)(p.ws + WS_BIASS) + (size_t)b * 8 * KVS : (float*)(p.ws + WS_BIASP) + (size_t)b * 8 * SEQ;
    const int ds = samp ? KVS : SEQ;
    float acc[8];
#pragma unroll
    for (int h = 0; h < 8; ++h) acc[h] = 0.f;
#pragma unroll 1
    for (int i0 = 0; i0 < 65; i0 += 13) {
        f32x4 a[13], bb[13];
#pragma unroll
        for (int i = 0; i < 13; ++i) { const int s0 = lane * 65 + i0 + i, s = s0 < n ? s0 : n - 1; const float* r = s < 4096 ? src0 + (size_t)s * 8 : src1 + (size_t)(s - 4096) * 8; a[i] = *(const f32x4*)r; bb[i] = *(const f32x4*)(r + 4); }
#pragma unroll
        for (int i = 0; i < 13; ++i) { const bool ok = lane * 65 + i0 + i < n;
#pragma unroll
            for (int h = 0; h < 4; ++h) { acc[h] += ok ? a[i][h] : 0.f; acc[4 + h] += ok ? bb[i][h] : 0.f; } }
    }
    float run[8];
#pragma unroll
    for (int h = 0; h < 8; ++h) { float v = acc[h];
#pragma unroll
        for (int o = 1; o < 64; o <<= 1) { const float t = __shfl_up(v, o); if (lane >= o) v += t; }
        run[h] = v - acc[h]; }
#pragma unroll 1
    for (int i0 = 0; i0 < 65; i0 += 13) {
        f32x4 a[13], bb[13];
#pragma unroll
        for (int i = 0; i < 13; ++i) { const int s0 = lane * 65 + i0 + i, s = s0 < n ? s0 : n - 1; const float* r = s < 4096 ? src0 + (size_t)s * 8 : src1 + (size_t)(s - 4096) * 8; a[i] = *(const f32x4*)r; bb[i] = *(const f32x4*)(r + 4); }
#pragma unroll
        for (int i = 0; i < 13; ++i) { const int s = lane * 65 + i0 + i; if (s < n) {
#pragma unroll
            for (int h = 0; h < 4; ++h) { run[h] += a[i][h]; run[4 + h] += bb[i][h]; dst[(size_t)h * ds + s] = -run[h] * LOG2E; dst[(size_t)(4 + h) * ds + s] = -run[4 + h] * LOG2E; } } }
    }
}

__device__ __forceinline__ void norm_rows(const bf16* base, int r0, int nrows, int h, unsigned* dst, int lane) {
    float mx = 0.f;
    const bf16* bp = base + (size_t)(r0 + (lane >> 3)) * 512 + h * 64 + (lane & 7) * 8;
    const int nit = (nrows + 7) >> 3;
    for (int it0 = 0; it0 < nit; it0 += 8) {
        u32x4 w[8];
#pragma unroll
        for (int k = 0; k < 8; ++k) { int it = it0 + k; const int rr = 8 * it + (lane >> 3); const int itc = (rr < nrows) ? it : 0; w[k] = *(const u32x4*)(bp + (size_t)itc * 8 * 512); }
#pragma unroll
        for (int k = 0; k < 8; ++k) {
            float ss = 0.f;
#pragma unroll
            for (int j = 0; j < 4; ++j) { const float lo = __uint_as_float(w[k][j] << 16), hi2 = __uint_as_float(w[k][j] & 0xFFFF0000u); ss += lo * lo + hi2 * hi2; }
            ss += __int_as_float(dpp_mov<0xB1>(__float_as_int(ss))); ss += __int_as_float(dpp_mov<0x4E>(__float_as_int(ss))); ss += __int_as_float(dpp_mov<0x124>(__float_as_int(ss)));
            mx = fmaxf(mx, (lane & 4) ? 0.f : ss);
        }
    }
    unsigned mu = row_max16(__float_as_uint(mx));
    { auto rr = __builtin_amdgcn_permlane16_swap(mu, mu, false, false); mu = rr[0] > rr[1] ? rr[0] : rr[1]; }
    { auto rr = __builtin_amdgcn_permlane32_swap(mu, mu, false, false); mu = rr[0] > rr[1] ? rr[0] : rr[1]; }
    if (lane == 0) atomicMax(dst, mu);
}
__device__ __forceinline__ void norm_rows_f32(const float* base, int r0, int nrows, int h, unsigned* dst, int lane) {
    float mx = 0.f;
    const float* bp = base + (size_t)(r0 + (lane >> 4)) * 512 + h * 64 + (lane & 15) * 4;
    const int nit = (nrows + 3) >> 2;
    for (int it0 = 0; it0 < nit; it0 += 8) {
        f32x4 w[8];
#pragma unroll
        for (int k = 0; k < 8; ++k) { const int it = it0 + k; const int rr = 4 * it + (lane >> 4); const int itc = (rr < nrows) ? it : 0; w[k] = *(const f32x4*)(bp + (size_t)itc * 4 * 512); }
#pragma unroll
        for (int k = 0; k < 8; ++k) { float ss = (w[k][0] * w[k][0] + w[k][1] * w[k][1]) + (w[k][2] * w[k][2] + w[k][3] * w[k][3]);
            ss = row_sum16(ss); mx = fmaxf(mx, ss); }
    }
    unsigned mu = __float_as_uint(mx);
    { auto rr = __builtin_amdgcn_permlane16_swap(mu, mu, false, false); mu = rr[0] > rr[1] ? rr[0] : rr[1]; }
    { auto rr = __builtin_amdgcn_permlane32_swap(mu, mu, false, false); mu = rr[0] > rr[1] ? rr[0] : rr[1]; }
    if (lane == 0) atomicMax(dst, mu);
}
__device__ __forceinline__ void conv_item(const KP& p, const Ctx& c, int j) {
    const int b = j / 80, r = j % 80;
    const float* src; bf16* dst; size_t off;
    if (r < 32) { src = p.cfk + (size_t)b * 4096 * 512; dst = (bf16*)(p.ws + WS_FKA) + (size_t)b * KVS * 512; off = (size_t)r * 65536; }
    else if (r < 64) { src = p.cfv + (size_t)b * 4096 * 512; dst = (bf16*)(p.ws + WS_FVA) + (size_t)b * KVS * 512; off = (size_t)(r - 32) * 65536; }
    else if (r < 72) { src = p.cdk + (size_t)b * 4096 * 128; dst = (bf16*)(p.ws + WS_DKA) + (size_t)b * KVS * 128; off = (size_t)(r - 64) * 65536; }
    else { src = p.cdv + (size_t)b * 4096 * 128; dst = (bf16*)(p.ws + WS_DVA) + (size_t)b * KVS * 128; off = (size_t)(r - 72) * 65536; }
    src += off + (size_t)c.tid * 8; dst += off + (size_t)c.tid * 8;
#pragma unroll 1
    for (int i0 = 0; i0 < 16; i0 += 4) {
        f32x4 a[4], bb[4];
#pragma unroll
        for (int u = 0; u < 4; ++u) { a[u] = *(const f32x4*)(src + (size_t)(i0 + u) * 4096); bb[u] = *(const f32x4*)(src + (size_t)(i0 + u) * 4096 + 4); }
#pragma unroll
        for (int u = 0; u < 4; ++u) { u32x4 o; o.x = pk2(a[u][0], a[u][1]); o.y = pk2(a[u][2], a[u][3]); o.z = pk2(bb[u][0], bb[u][1]); o.w = pk2(bb[u][2], bb[u][3]); *(u32x4*)(dst + (size_t)(i0 + u) * 4096) = o; }
    }
}
__device__ __forceinline__ unsigned f2key(float f) { const unsigned u = __float_as_uint(f); return (u & 0x80000000u) ? ~u : (u | 0x80000000u); }
__device__ __forceinline__ int crow(int r, int hi) { return (r & 3) + 8 * (r >> 2) + 4 * hi; }

__device__ __forceinline__ int count8_ge(unsigned mid, unsigned k0, unsigned k1, unsigned k2, unsigned k3, unsigned k4, unsigned k5, unsigned k6, unsigned k7) {
    unsigned long long m0, m1, m2, m3, m4, m5, m6, m7;
    asm("v_cmp_le_u32_e64 %0, %8, %9\n\tv_cmp_le_u32_e64 %1, %8, %10\n\tv_cmp_le_u32_e64 %2, %8, %11\n\tv_cmp_le_u32_e64 %3, %8, %12\n\t"
        "v_cmp_le_u32_e64 %4, %8, %13\n\tv_cmp_le_u32_e64 %5, %8, %14\n\tv_cmp_le_u32_e64 %6, %8, %15\n\tv_cmp_le_u32_e64 %7, %8, %16"
        : "=&s"(m0), "=&s"(m1), "=&s"(m2), "=&s"(m3), "=&s"(m4), "=&s"(m5), "=&s"(m6), "=&s"(m7)
        : "s"(mid), "v"(k0), "v"(k1), "v"(k2), "v"(k3), "v"(k4), "v"(k5), "v"(k6), "v"(k7));
    return (__popcll(m0) + __popcll(m1)) + (__popcll(m2) + __popcll(m3)) + ((__popcll(m4) + __popcll(m5)) + (__popcll(m6) + __popcll(m7)));
}
template <int L0> __device__ __forceinline__ void words8_ge(unsigned t, int& wlo, int& whi, unsigned k0, unsigned k1, unsigned k2, unsigned k3, unsigned k4, unsigned k5, unsigned k6, unsigned k7) {
    unsigned long long m0, m1, m2, m3, m4, m5, m6, m7;
    asm volatile("v_cmp_le_u32_e64 %0, %8, %9\n\tv_cmp_le_u32_e64 %1, %8, %10\n\tv_cmp_le_u32_e64 %2, %8, %11\n\tv_cmp_le_u32_e64 %3, %8, %12\n\t"
        "v_cmp_le_u32_e64 %4, %8, %13\n\tv_cmp_le_u32_e64 %5, %8, %14\n\tv_cmp_le_u32_e64 %6, %8, %15\n\tv_cmp_le_u32_e64 %7, %8, %16"
        : "=&s"(m0), "=&s"(m1), "=&s"(m2), "=&s"(m3), "=&s"(m4), "=&s"(m5), "=&s"(m6), "=&s"(m7)
        : "s"(t), "v"(k0), "v"(k1), "v"(k2), "v"(k3), "v"(k4), "v"(k5), "v"(k6), "v"(k7));
#define WL_(m, L) asm volatile("v_writelane_b32 %0, %2, %4\n\tv_writelane_b32 %1, %3, %4" : "+v"(wlo), "+v"(whi) : "s"((int)(unsigned)(m)), "s"((int)(unsigned)((m) >> 32)), "n"(L))
    WL_(m0, L0); WL_(m1, L0 + 1); WL_(m2, L0 + 2); WL_(m3, L0 + 3); WL_(m4, L0 + 4); WL_(m5, L0 + 5); WL_(m6, L0 + 6); WL_(m7, L0 + 7);
#undef WL_
}
__device__ __forceinline__ void load_row(float (&v)[65], const float* row, int N, int lane) {
    const float* r0 = row + lane; asm volatile("" : "+v"(r0));
    const __attribute__((address_space(1))) float* r = (const __attribute__((address_space(1))) float*)r0;
#pragma unroll
    for (int j = 0; j < 8; ++j) if (512 * j < N) {
#pragma unroll
        for (int i = 8 * j; i < 8 * j + 8; ++i) v[i] = r[64 * i];
    }
    if (N > 4096) v[64] = r[4096];
}
__device__ __forceinline__ void keys_from_row(unsigned (&key)[65], const float (&v)[65], int N, int lane) {
#pragma unroll
    for (int j = 0; j < 8; ++j) {
        if (512 * j < N) {
#pragma unroll
            for (int i = 8 * j; i < 8 * j + 8; ++i) key[i] = f2key(v[i]);
        } else {
#pragma unroll
            for (int i = 8 * j; i < 8 * j + 8; ++i) key[i] = 0u;
        }
    }
    key[64] = (N > 4096 && lane < N - 4096) ? f2key(v[64]) : 0u;
}
__device__ __forceinline__ void select_query(const unsigned (&key)[65], int N, unsigned long long* mrow, LAS unsigned long long* lw, int lane) {
    if (N <= 256) { mrow[lane] = (64 * lane < N) ? ~0ull : 0ull; return; }
    unsigned lo = 0u, hi = 0xFFFFFFFFu; int clo = N; bool exact = false;
    {
        unsigned mk = 0u;
#pragma unroll
        for (int j = 0; j < 8; ++j) if (512 * j < N) {
#pragma unroll
            for (int i = 8 * j; i < 8 * j + 8; ++i) mk = mk > key[i] ? mk : key[i];
        }
        mk = mk > key[64] ? mk : key[64];
        { auto rr = __builtin_amdgcn_permlane32_swap(mk, mk, false, false); mk = rr[0] > rr[1] ? rr[0] : rr[1]; }
        { auto rr = __builtin_amdgcn_permlane16_swap(mk, mk, false, false); mk = rr[0] > rr[1] ? rr[0] : rr[1]; }
        mk = row_max16(mk);
        mk = (unsigned)__builtin_amdgcn_readfirstlane((int)mk);
        if (mk != 0xFFFFFFFFu) hi = mk + 1u;
        if (mk >= 0x80000000u + (6u << 23)) {
            const unsigned lc = mk - (6u << 23); int cnt = 0;
#pragma unroll
            for (int j = 0; j < 8; ++j) if (512 * j < N) cnt += count8_ge(lc, key[8 * j], key[8 * j + 1], key[8 * j + 2], key[8 * j + 3], key[8 * j + 4], key[8 * j + 5], key[8 * j + 6], key[8 * j + 7]);
            if (N > 4096) cnt += __popcll(__ballot(key[64] >= lc));
            if (cnt >= 256) { lo = lc; clo = cnt; exact = (cnt == 256); }
        }
    }
    if (!exact) {
        int chi = 0; bool bis = false;
        for (;;) {
            const unsigned span = hi - lo;
            if (span <= 1u) break;
            unsigned mid = lo + (span >> 1);
            if (!bis && lo >= 0x80000000u) {
                const float lv = __uint_as_float(lo & 0x7FFFFFFFu), hv = __uint_as_float(hi & 0x7FFFFFFFu);
                const float lc = __log2f((float)clo), lh = __log2f(chi > 0 ? (float)chi : 0.5f);
                const float f = (lc - 8.0f) / (lc - lh);
                const unsigned g = __float_as_uint(lv + (hv - lv) * f) | 0x80000000u;
                mid = g <= lo ? lo + 1u : (g >= hi ? hi - 1u : g);
            }
            bis = !bis;
            int cnt = 0;
#pragma unroll
            for (int j = 0; j < 8; ++j) if (512 * j < N) cnt += count8_ge(mid, key[8 * j], key[8 * j + 1], key[8 * j + 2], key[8 * j + 3], key[8 * j + 4], key[8 * j + 5], key[8 * j + 6], key[8 * j + 7]);
            if (N > 4096) cnt += __popcll(__ballot(key[64] >= mid));
            if (cnt >= 256) { lo = mid; clo = cnt; if (cnt == 256) { exact = true; break; } } else { hi = mid; chi = cnt; }
        }
    }
    if (exact) {
        int wlo = 0, whi = 0;
#define W8_(j) if (512 * (j) < N) words8_ge<8 * (j)>(lo, wlo, whi, key[8 * (j)], key[8 * (j) + 1], key[8 * (j) + 2], key[8 * (j) + 3], key[8 * (j) + 4], key[8 * (j) + 5], key[8 * (j) + 6], key[8 * (j) + 7]);
        W8_(0) W8_(1) W8_(2) W8_(3) W8_(4) W8_(5) W8_(6) W8_(7)
#undef W8_
        mrow[lane] = ((unsigned long long)(unsigned)whi << 32) | (unsigned)wlo;
        if (N > 4096) { const unsigned long long w = __ballot(key[64] >= lo); if (lane == 0) mrow[64] = w; }
        return;
    } else {
        int cgt = 0;
#pragma unroll
        for (int j = 0; j < 9; ++j) if (512 * j < N) {
#pragma unroll
            for (int i = 8 * j; i < 8 * j + 8 && i < 65; ++i) cgt += __popcll(__ballot(key[i] > lo));
        }
        const int need = 256 - cgt; int taken = 0; const unsigned long long lt = (1ull << lane) - 1ull;
#pragma unroll
        for (int j = 0; j < 9; ++j) if (512 * j < N) {
#pragma unroll
            for (int i = 8 * j; i < 8 * j + 8 && i < 65; ++i) {
                const bool gt = key[i] > lo, eq = key[i] == lo;
                const unsigned long long tb = __ballot(eq);
                const int rank = taken + __popcll(tb & lt);
                const bool sel = gt || (eq && rank < need);
                taken += __popcll(tb);
                const unsigned long long w = __ballot(sel);
                if (lane == 0) lw[i] = w;
            }
        }
    }
    (void)clo;
    LDS_WAIT();
    const int nw = (N + 63) >> 6;
    if (lane < nw) mrow[lane] = lw[lane];
    if (lane == 0 && nw > 64) mrow[64] = lw[64];
    LDS_WAIT();
}

__device__ __forceinline__ void idx_unit(const KP& p, const Ctx& c, int b, int ch, int half, float* scr) {
    const int lane = c.lane, wid = c.wid, r32 = lane & 31, hi = lane >> 5;
    const bool samp = ch < 0;
    const int N = samp ? NKEY_S : 64 * (ch + 1);
    const size_t qrow0 = samp ? (size_t)MP + b * 32 : (size_t)b * 4096 + 64 * ch + 32 * half;
    const bf16* ikb = samp ? (const bf16*)(p.ws + WS_IKA) + (size_t)b * KVS * 64 : (const bf16*)(p.ws + WS_IKP) + (size_t)b * 4096 * 64;
    const int nst = N / 32;
    {
        bf16x8 qf[4][4]; const bf16* qp = (const bf16*)(p.ws + WS_IQ) + (qrow0 + r32) * 256 + hi * 8;
#pragma unroll
        for (int h = 0; h < 4; ++h)
#pragma unroll
            for (int ks = 0; ks < 4; ++ks) qf[h][ks] = *(const bf16x8*)(qp + h * 64 + ks * 16);
        f32x4 wq[16];
#pragma unroll
        for (int r = 0; r < 16; ++r) wq[r] = *(const f32x4*)((const float*)(p.ws + WS_IW) + (qrow0 + crow(r, hi)) * 4);
        bf16x8 a[4];
        if (wid < nst) { const bf16* kp = ikb + (size_t)(32 * wid + r32) * 64 + hi * 8;
#pragma unroll
          for (int ks = 0; ks < 4; ++ks) a[ks] = *(const bf16x8*)(kp + ks * 16); }
        for (int st = wid; st < nst; st += 8) {
            bf16x8 an[4];
            if (st + 8 < nst) { const bf16* kp = ikb + (size_t)(32 * (st + 8) + r32) * 64 + hi * 8;
#pragma unroll
                for (int ks = 0; ks < 4; ++ks) an[ks] = *(const bf16x8*)(kp + ks * 16); }
            f32x16 sc;
#pragma unroll
            for (int r = 0; r < 16; ++r) sc[r] = 0.f;
#pragma unroll
            for (int h = 0; h < 4; ++h) { f32x16 d;
#pragma unroll
                for (int r = 0; r < 16; ++r) d[r] = 0.f;
#pragma unroll
                for (int ks = 0; ks < 4; ++ks) d = __builtin_amdgcn_mfma_f32_32x32x16_bf16(qf[h][ks], a[ks], d, 0, 0, 0);
#pragma unroll
                for (int r = 0; r < 16; ++r) sc[r] += wq[r][h] * (d[r] > 0.f ? d[r] : 0.f); }
            float* sp = scr + (size_t)(4 * hi) * SCR_LD + 32 * st + r32;
#pragma unroll
            for (int r = 0; r < 16; ++r) sp[(size_t)((r & 3) + 8 * (r >> 2)) * SCR_LD] = sc[r];
            if (st + 8 < nst) {
#pragma unroll
                for (int ks = 0; ks < 4; ++ks) a[ks] = an[ks]; }
        }
    }
    if (N < 4096 && (N & 511)) {
        const int pad = 512 - (N & 511);
        for (int rr = wid; rr < 32; rr += 8) for (int kk = lane; kk < pad; kk += 64) scr[(size_t)rr * SCR_LD + N + kk] = -INFINITY;
    }
    __syncthreads();
    {
        float v[65];
        load_row(v, scr + (size_t)wid * SCR_LD, N, lane);
#pragma unroll 1
        for (int q = wid; q < 32; q += 8) {
            unsigned key[65];
            keys_from_row(key, v, N, lane);
            if (q + 8 < 32) load_row(v, scr + (size_t)(q + 8) * SCR_LD, N, lane);
            select_query(key, N, (unsigned long long*)(p.ws + WS_MASK) + (qrow0 + q) * MW, (LAS unsigned long long*)(c.lds + wid * 1024), lane);
        }
    }
    __syncthreads();
}

struct FU {
    const bf16* q; const bf16* kbase; const bf16* vbase; const float* bias; const unsigned long long* mask; bf16* o;
    int kvstride, ntiles, qpos, causal_from, wave_qmax, t_begin; bool valid;
};
constexpr int FT_ROW = 144, FT_VROW = 192  , FT_V = 64 * FT_ROW, FT_BIAS = FT_V + 64 * FT_VROW, FT_BUF = FT_BIAS + 256;
__device__ __forceinline__ s16x4 vtr(const LAS unsigned char* p) { return __builtin_bit_cast(s16x4, __builtin_amdgcn_ds_read_tr16_b64_v4i16((LAS s16x4*)p)); }

constexpr float FOX_THR = 24.f;
__device__ __forceinline__ float vmax3(float a, float b, float c) { float r; asm("v_max3_f32 %0, %1, %2, %3" : "=v"(r) : "v"(a), "v"(b), "v"(c)); return r; }
__device__ __forceinline__ float vmax2(float a, float b) { float r; asm("v_max_f32_e32 %0, %1, %2" : "=v"(r) : "v"(a), "v"(b)); return r; }
template <int BP> __device__ __forceinline__ unsigned bitmask1(int w) { int r; asm("v_bfe_i32 %0, %1, %2, 1" : "=v"(r) : "v"(w), "n"(BP)); return (unsigned)r; }
__device__ __forceinline__ void flash_tile(const FU& u, const LAS unsigned char* Kb, int t, unsigned long long mw, const bf16x8 (&qr)[4], float& m, f32x16& negm, float& l, f32x16& o0, f32x16& o1, int r32, int hi, int vlane) {
            const LAS unsigned char* Vb = Kb + FT_V;
            f32x16 c0, c1;
            if (u.bias) { const LAS float* bl = (const LAS float*)(Kb + FT_BIAS);
#pragma unroll
                for (int g = 0; g < 4; ++g) { const f32x4 t0 = *(const LAS f32x4*)(bl + 8 * g + 4 * hi), t1 = *(const LAS f32x4*)(bl + 32 + 8 * g + 4 * hi);
#pragma unroll
                    for (int j = 0; j < 4; ++j) { c0[4 * g + j] = t0[j] - m; c1[4 * g + j] = t1[j] - m; } }
            } else { c0 = negm; c1 = negm; }
#pragma unroll
            for (int ks = 0; ks < 4; ++ks) {
                const bf16x8 a0 = *(const LAS bf16x8*)(Kb + r32 * FT_ROW + ks * 32 + hi * 16), a1 = *(const LAS bf16x8*)(Kb + (32 + r32) * FT_ROW + ks * 32 + hi * 16);
                c0 = __builtin_amdgcn_mfma_f32_32x32x16_bf16(a0, qr[ks], c0, 0, 0, 0); c1 = __builtin_amdgcn_mfma_f32_32x32x16_bf16(a1, qr[ks], c1, 0, 0, 0);
            }
            if (t >= u.causal_from) { const int kb = 64 * t + 4 * hi;
#pragma unroll
                for (int r = 0; r < 16; ++r) { const int kv = kb + (r & 3) + 8 * (r >> 2); if (kv > u.qpos) c0[r] = -INFINITY; if (kv + 32 > u.qpos) c1[r] = -INFINITY; } }
            asm volatile("s_nop 15\n\ts_nop 7" : "+v"(c0), "+v"(c1));
            float ma = vmax3(c0[0], c0[1], c1[0]), mb = vmax3(c0[2], c0[3], c1[1]); ma = vmax3(ma, c1[2], c1[3]);
#pragma unroll
            for (int r = 4; r < 16; r += 4) { ma = vmax3(ma, c0[r], c0[r + 1]); mb = vmax3(mb, c0[r + 2], c0[r + 3]); ma = vmax3(ma, c1[r], c1[r + 1]); mb = vmax3(mb, c1[r + 2], c1[r + 3]); }
            float mx = vmax2(ma, mb); { auto rr = __builtin_amdgcn_permlane32_swap(__float_as_uint(mx), __float_as_uint(mx), false, false); mx = vmax2(__uint_as_float(rr[0]), __uint_as_float(rr[1])); }
            if (u.bias && !__any(mx > -FOX_THR)) return;
            if (__any(mx > 8.f)) {
                const float dl = vmax2(mx, 0.f), al = __builtin_amdgcn_exp2f(-dl); m += dl; l *= al;
#pragma unroll
                for (int r = 0; r < 16; ++r) { o0[r] *= al; o1[r] *= al; c0[r] -= dl; c1[r] -= dl; negm[r] = -m; }
            }
#pragma unroll
            for (int r = 0; r < 16; ++r) { c0[r] = __builtin_amdgcn_exp2f(c0[r]); c1[r] = __builtin_amdgcn_exp2f(c1[r]); }
            if (u.mask) {
                const int lo = (int)((unsigned)mw >> (4 * hi)), hw = (int)((unsigned)(mw >> 32) >> (4 * hi));
#define MK(r) { c0[r] = __uint_as_float(__float_as_uint(c0[r]) & bitmask1<((r) & 3) + 8 * ((r) >> 2)>(lo)); c1[r] = __uint_as_float(__float_as_uint(c1[r]) & bitmask1<((r) & 3) + 8 * ((r) >> 2)>(hw)); }
                MK(0) MK(1) MK(2) MK(3) MK(4) MK(5) MK(6) MK(7) MK(8) MK(9) MK(10) MK(11) MK(12) MK(13) MK(14) MK(15)
#undef MK
            }
            float ps = 0.f;
#pragma unroll
            for (int r = 0; r < 16; ++r) ps += c0[r] + c1[r];
            l += ps;
            bf16x8 pf[4];
#pragma unroll
            for (int s = 0; s < 2; ++s) {
                u32x4 w0, w1;
                w0.x = pk2(c0[8 * s + 0], c0[8 * s + 1]); w0.y = pk2(c0[8 * s + 2], c0[8 * s + 3]); w0.z = pk2(c0[8 * s + 4], c0[8 * s + 5]); w0.w = pk2(c0[8 * s + 6], c0[8 * s + 7]);
                w1.x = pk2(c1[8 * s + 0], c1[8 * s + 1]); w1.y = pk2(c1[8 * s + 2], c1[8 * s + 3]); w1.z = pk2(c1[8 * s + 4], c1[8 * s + 5]); w1.w = pk2(c1[8 * s + 6], c1[8 * s + 7]);
                pf[s] = __builtin_bit_cast(bf16x8, w0); pf[2 + s] = __builtin_bit_cast(bf16x8, w1);
            }
            const LAS unsigned char* vp = Vb + vlane;
#pragma unroll
            for (int s = 0; s < 4; ++s) {
                const s16x4 a_lo0 = vtr(vp + (16 * s) * FT_VROW), a_hi0 = vtr(vp + (16 * s + 8) * FT_VROW);
                const s16x4 a_lo1 = vtr(vp + (16 * s) * FT_VROW + 64), a_hi1 = vtr(vp + (16 * s + 8) * FT_VROW + 64);
                const bf16x8 A0 = (bf16x8){a_lo0[0], a_lo0[1], a_lo0[2], a_lo0[3], a_hi0[0], a_hi0[1], a_hi0[2], a_hi0[3]};
                const bf16x8 A1 = (bf16x8){a_lo1[0], a_lo1[1], a_lo1[2], a_lo1[3], a_hi1[0], a_hi1[1], a_hi1[2], a_hi1[3]};
                o0 = __builtin_amdgcn_mfma_f32_32x32x16_bf16(A0, pf[s], o0, 0, 0, 0); o1 = __builtin_amdgcn_mfma_f32_32x32x16_bf16(A1, pf[s], o1, 0, 0, 0);
            }
}
__device__ __forceinline__ void flash_unit(const FU& u, const Ctx& c) {
    const int tid = c.tid, lane = c.lane, r32 = lane & 31, hi = lane >> 5;
    LAS unsigned char* lds = c.lds;
    const int lrow = tid >> 3, lch = tid & 7;
    const bf16* kg = u.kbase + (size_t)lrow * u.kvstride + lch * 8;
    const bf16* vg = u.vbase + (size_t)lrow * u.kvstride + lch * 8;
    const size_t tstep = (size_t)64 * u.kvstride;
    const int loff = lrow * FT_ROW + lch * 16, loffv = lrow * FT_VROW + lch * 16;
    const int t0 = u.t_begin, tl = u.ntiles - 1, n = tl - t0 + 1;
    u32x4 kA, vA, kB, vB; float bA = 0.f, bB = 0.f; unsigned long long mA = 0ull, mB = 0ull, mC = 0ull;
#define FL_BAR() asm volatile("s_waitcnt lgkmcnt(0)\n\ts_barrier" ::: "memory")
#define FL_LOAD(S, tt) do { k##S = *(const u32x4*)(kg + (size_t)(tt) * tstep); v##S = *(const u32x4*)(vg + (size_t)(tt) * tstep); if (u.bias) b##S = u.bias[(tt) * 64 + (tid & 63)]; if (u.mask) m##S = u.mask[tt]; } while (0)
#define FL_STORE(bufi, S) do { LAS unsigned char* nb_ = lds + (bufi) * FT_BUF; *(LAS u32x4*)(nb_ + loff) = k##S; *(LAS u32x4*)(nb_ + FT_V + loffv) = v##S; if (tid < 64) *(LAS float*)(nb_ + FT_BIAS + tid * 4) = b##S; } while (0)
    FL_LOAD(A, tl); FL_LOAD(B, (tl - 1 > t0 ? tl - 1 : t0));
    bf16x8 qr[4];
    if (u.valid) {
#pragma unroll
        for (int ks = 0; ks < 4; ++ks) qr[ks] = *(const bf16x8*)(u.q + ks * 16 + hi * 8);
    }
    FL_STORE(0, A); FL_STORE(1, B); mC = mA; unsigned long long mD = mB;
    float m = 0.f, l = 0.f; f32x16 o0, o1, negm;
#pragma unroll
    for (int r = 0; r < 16; ++r) { o0[r] = 0.f; o1[r] = 0.f; negm[r] = 0.f; }
    const int vlane = (4 * hi + ((lane & 15) >> 2)) * FT_VROW + (16 * ((lane >> 4) & 1) + 4 * (lane & 3)) * 2;
    FL_BAR();
    for (int i = 0; i < n; i += 2) {
        const int ta = tl - i, tb = tl - i - 1;
        { const int tn = tl - i - 2, tm = tl - i - 3; FL_LOAD(A, (tn > t0 ? tn : t0)); FL_LOAD(B, (tm > t0 ? tm : t0)); }
        if (u.valid && !(ta >= u.causal_from && 64 * ta > u.wave_qmax)) flash_tile(u, lds, ta, mC, qr, m, negm, l, o0, o1, r32, hi, vlane);
        if (tb >= t0 && u.valid && !(tb >= u.causal_from && 64 * tb > u.wave_qmax)) flash_tile(u, lds + FT_BUF, tb, mD, qr, m, negm, l, o0, o1, r32, hi, vlane);
        FL_BAR();
        FL_STORE(0, A); FL_STORE(1, B); mC = mA; mD = mB;
        FL_BAR();
    }
#undef FL_LOAD
#undef FL_BAR
#undef FL_STORE
    if (u.valid) {
        l = pg8::add_xor32(l); const float inv = 1.0f / l;
#pragma unroll
        for (int g = 0; g < 4; ++g) {
            u32x2 w0, w1;
            w0.x = pk2(o0[4 * g] * inv, o0[4 * g + 1] * inv); w0.y = pk2(o0[4 * g + 2] * inv, o0[4 * g + 3] * inv);
            w1.x = pk2(o1[4 * g] * inv, o1[4 * g + 1] * inv); w1.y = pk2(o1[4 * g + 2] * inv, o1[4 * g + 3] * inv);
            *(u32x2*)(u.o + 8 * g + 4 * hi) = w0; *(u32x2*)(u.o + 32 + 8 * g + 4 * hi) = w1;
        }
    }
}

__device__ __forceinline__ int fox_first_tile(const unsigned* nrm, const float* bias, int row0, int ntl, int lane) {
    const float q2 = __uint_as_float(nrm[0]), k2 = __uint_as_float(nrm[1]);
    const float slack = 2.0f * sqrtf(q2 * k2) * 1.01f + FOX_THR - bias[row0];
    const bool skip = (lane < ntl) && (slack + bias[64 * (lane < ntl ? lane : 0) + 63] < 0.f);
    const unsigned long long bal = __ballot(skip);
    const int t0 = __ffsll((long long)~bal) - 1;
    return (~bal == 0ull) ? ntl : (t0 < ntl ? t0 : ntl);
}
__device__ __forceinline__ void attn_fox_p(const KP& p, const Ctx& c, int b, int h, int qb) {
    const int r32 = c.lane & 31; const int pos = 256 * qb + 32 * c.wid + r32; const size_t row = (size_t)b * 4096 + pos;
    FU u; u.q = (const bf16*)(p.ws + WS_FQ) + row * 512 + h * 64; u.kbase = (const bf16*)(p.ws + WS_FKP) + (size_t)b * 4096 * 512 + h * 64; u.vbase = (const bf16*)(p.ws + WS_FVP) + (size_t)b * 4096 * 512 + h * 64;
    u.bias = (const float*)(p.ws + WS_BIASP) + (size_t)(b * 8 + h) * SEQ; u.mask = nullptr; u.o = (bf16*)(p.ws + WS_AO) + row * DM + h * 64;
    u.kvstride = 512; u.ntiles = 4 * qb + 4; u.qpos = pos; u.causal_from = 4 * qb; u.wave_qmax = 256 * qb + 32 * c.wid + 31; u.valid = true;
    u.t_begin = fox_first_tile((const unsigned*)(p.ws + WS_NORM) + (b * 8 + h) * 2, u.bias, 256 * qb, 4 * qb, c.lane);
    flash_unit(u, c);
}
__device__ __forceinline__ void attn_fox_s(const KP& p, const Ctx& c, int b, int h) {
    const int r32 = c.lane & 31; const size_t row = (size_t)MP + b * 32 + r32;
    FU u; u.q = (const bf16*)(p.ws + WS_FQ) + row * 512 + h * 64; u.kbase = (const bf16*)(p.ws + WS_FKA) + (size_t)b * KVS * 512 + h * 64; u.vbase = (const bf16*)(p.ws + WS_FVA) + (size_t)b * KVS * 512 + h * 64;
    u.bias = (const float*)(p.ws + WS_BIASS) + (size_t)(b * 8 + h) * KVS; u.mask = nullptr; u.o = (bf16*)(p.ws + WS_AO) + row * DM + h * 64;
    u.kvstride = 512; u.ntiles = 65; u.qpos = 4096 + r32; u.causal_from = 64; u.wave_qmax = 4127; u.valid = (c.wid == 0);
    u.t_begin = fox_first_tile((const unsigned*)(p.ws + WS_NORM) + ((16 + b) * 8 + h) * 2, u.bias, 4096, 64, c.lane);
    flash_unit(u, c);
}
__device__ __forceinline__ void attn_dsa_p(const KP& p, const Ctx& c, int b, int ch, int g) {
    const int r32 = c.lane & 31; const int hh = 4 * g + (c.wid >> 1); const size_t row = (size_t)b * 4096 + 64 * ch + 32 * (c.wid & 1) + r32;
    FU u; u.q = (const bf16*)(p.ws + WS_DQ) + row * 512 + hh * 64; u.kbase = (const bf16*)(p.ws + WS_DKP) + (size_t)b * 4096 * 128 + g * 64; u.vbase = (const bf16*)(p.ws + WS_DVP) + (size_t)b * 4096 * 128 + g * 64;
    u.bias = nullptr; u.mask = (const unsigned long long*)(p.ws + WS_MASK) + row * MW; u.o = (bf16*)(p.ws + WS_AO) + row * DM + 512 + hh * 64;
    u.kvstride = 128; u.ntiles = ch + 1; u.qpos = 0; u.causal_from = ch + 1; u.wave_qmax = 0; u.valid = true; u.t_begin = 0;
    flash_unit(u, c);
}
__device__ __forceinline__ void attn_dsa_s(const KP& p, const Ctx& c, int b, int g) {
    const int r32 = c.lane & 31; const int hh = 4 * g + (c.wid & 3); const size_t row = (size_t)MP + b * 32 + r32;
    FU u; u.q = (const bf16*)(p.ws + WS_DQ) + row * 512 + hh * 64; u.kbase = (const bf16*)(p.ws + WS_DKA) + (size_t)b * KVS * 128 + g * 64; u.vbase = (const bf16*)(p.ws + WS_DVA) + (size_t)b * KVS * 128 + g * 64;
    u.bias = nullptr; u.mask = (const unsigned long long*)(p.ws + WS_MASK) + row * MW; u.o = (bf16*)(p.ws + WS_AO) + row * DM + 512 + hh * 64;
    u.kvstride = 128; u.ntiles = 65; u.qpos = 0; u.causal_from = 65; u.wave_qmax = 0; u.valid = (c.wid < 4); u.t_begin = 0;
    flash_unit(u, c);
}

__device__ __forceinline__ void ln1_apply(const Ctx& c, const float* z, const float* stats, const float* gam, const float* bet, bf16* outb, float* rowstat) {
    for (int row0 = c.gw; row0 < MT; row0 += 2 * c.ngw) {
        float s[2], q[2]; f32x4 v[2][4];
#pragma unroll
        for (int e = 0; e < 2; ++e) { const int row = row0 + e * c.ngw < MT ? row0 + e * c.ngw : row0;
            s[e] = 0.f; q[e] = 0.f; if (c.lane < 16) { const float* sp = stats + ((size_t)row * 16 + c.lane) * 2; s[e] = sp[0]; q[e] = sp[1]; }
            const float* zr = z + (size_t)row * DM;
#pragma unroll
            for (int j = 0; j < 4; ++j) v[e][j] = *(const f32x4*)(zr + 256 * j + 4 * c.lane); }
#pragma unroll
        for (int e = 0; e < 2; ++e) { const int row = row0 + e * c.ngw; if (row < MT) {
            float ss = s[e], qq = q[e];
            ss = __builtin_amdgcn_readfirstlane(row_sum16(ss)); qq = __builtin_amdgcn_readfirstlane(row_sum16(qq));
            const float mean = ss * (1.f / DM), var = fmaxf(qq * (1.f / DM) - mean * mean, 0.f), rstd = 1.0f / sqrtf(var + LN_EPS);
            if (c.lane == 0) { rowstat[2 * (size_t)row] = mean; rowstat[2 * (size_t)row + 1] = rstd; }
#pragma unroll
            for (int j = 0; j < 4; ++j) { const int col = 256 * j + 4 * c.lane;
                const f32x4 gg = *(const f32x4*)(gam + col), bb = *(const f32x4*)(bet + col);
                const f32x4 o = (v[e][j] - mean) * rstd * gg + bb;
                u32x2 w; w.x = pk2(o[0], o[1]); w.y = pk2(o[2], o[3]); *(u32x2*)(outb + (size_t)row * DM + col) = w; } } }
    }
}
__device__ __forceinline__ void ln2_apply(const Ctx& c, const bf16* z2b, const float* stats, const float* gam, const float* bet, float* outf) {
    for (int row0 = c.gw; row0 < MT; row0 += 2 * c.ngw) {
        float s[2], q[2]; u32x2 v[2][4];
#pragma unroll
        for (int e = 0; e < 2; ++e) { const int row = row0 + e * c.ngw < MT ? row0 + e * c.ngw : row0;
            s[e] = 0.f; q[e] = 0.f; if (c.lane < 16) { const float* sp = stats + ((size_t)row * 16 + c.lane) * 2; s[e] = sp[0]; q[e] = sp[1]; }
            const bf16* zr = z2b + (size_t)row * DM;
#pragma unroll
            for (int j = 0; j < 4; ++j) v[e][j] = *(const u32x2*)(zr + 256 * j + 4 * c.lane); }
#pragma unroll
        for (int e = 0; e < 2; ++e) { const int row = row0 + e * c.ngw; if (row < MT) {
            float ss = s[e], qq = q[e];
            ss = __builtin_amdgcn_readfirstlane(row_sum16(ss)); qq = __builtin_amdgcn_readfirstlane(row_sum16(qq));
            const float mean = ss * (1.f / DM), var = fmaxf(qq * (1.f / DM) - mean * mean, 0.f), rstd = 1.0f / sqrtf(var + LN_EPS);
#pragma unroll
            for (int j = 0; j < 4; ++j) { const int col = 256 * j + 4 * c.lane;
                const f32x4 gg = *(const f32x4*)(gam + col), bb = *(const f32x4*)(bet + col);
                const f32x4 x = (f32x4){__uint_as_float(v[e][j].x << 16), __uint_as_float(v[e][j].x & 0xFFFF0000u), __uint_as_float(v[e][j].y << 16), __uint_as_float(v[e][j].y & 0xFFFF0000u)};
                *(f32x4*)(outf + (size_t)row * DM + col) = (x - mean) * rstd * gg + bb; } } }
    }
}

struct MiniArgs { const bf16* A; const bf16* Bt; int K; const float* xs; float* z; float* stats; bf16* act; const float* rowstat; const float* g1; const float* b1; bf16* z2b; };
template <int MODE> __device__ __forceinline__ void mini_tile(const MiniArgs& a, const Ctx& c, int rt, int ct) {
    const int lane = c.lane, wid = c.wid, r32 = lane & 31, hi = lane >> 5;
    const int row0 = MP + 32 * rt;
    const int brow0 = MODE == 1 ? 256 * (ct >> 2) + 32 * (ct & 3) : 64 * ct, brow1 = MODE == 1 ? brow0 + 128 : brow0 + 32;
    const int K = a.K, nks = K / 16;
    const bf16* ap = a.A + (size_t)(row0 + r32) * K + 8 * hi;
    const bf16* b0p = a.Bt + (size_t)(brow0 + r32) * K + 8 * hi;
    const bf16* b1p = a.Bt + (size_t)(brow1 + r32) * K + 8 * hi;
    f32x16 c0, c1;
#pragma unroll
    for (int r = 0; r < 16; ++r) { c0[r] = 0.f; c1[r] = 0.f; }
    for (int ks0 = wid; ks0 < nks; ks0 += 32) {
        bf16x8 av[4], bv0[4], bv1[4];
#pragma unroll
        for (int u = 0; u < 4; ++u) { const int ks = ks0 + 8 * u; const int kc = ks < nks ? ks : ks0; av[u] = *(const bf16x8*)(ap + 16 * kc); bv0[u] = *(const bf16x8*)(b0p + 16 * kc); bv1[u] = *(const bf16x8*)(b1p + 16 * kc); }
#pragma unroll
        for (int u = 0; u < 4; ++u) if (ks0 + 8 * u < nks) { c0 = __builtin_amdgcn_mfma_f32_32x32x16_bf16(av[u], bv0[u], c0, 0, 0, 0); c1 = __builtin_amdgcn_mfma_f32_32x32x16_bf16(av[u], bv1[u], c1, 0, 0, 0); }
    }
    LAS float* red = (LAS float*)c.lds;
#pragma unroll
    for (int r = 0; r < 16; ++r) { red[((wid * 2 + 0) * 16 + r) * 64 + lane] = c0[r]; red[((wid * 2 + 1) * 16 + r) * 64 + lane] = c1[r]; }
    __syncthreads();
#pragma unroll
    for (int e = 0; e < 2; ++e) {
        const int r = 2 * wid + e; float v0 = 0.f, v1 = 0.f;
#pragma unroll
        for (int w = 0; w < 8; ++w) { v0 += red[((w * 2 + 0) * 16 + r) * 64 + lane]; v1 += red[((w * 2 + 1) * 16 + r) * 64 + lane]; }
        const int row = row0 + (r & 3) + 8 * (r >> 2) + 4 * hi;
        if (MODE == 1) {
            const float g = v0; const float o = g * __builtin_amdgcn_rcpf(1.f + __expf(-g)) * v1;
            a.act[(size_t)row * DFF + 32 * ct + r32] = (bf16)(pk2(o, 0.f) & 0xFFFFu);
        } else {
            const int col = 64 * ct + r32; float z0, z1;
            if (MODE == 0) { const float* xr = a.xs + (size_t)(row - MP) * DM + col; z0 = xr[0] * ALPHA + v0; z1 = xr[32] * ALPHA + v1; float* zr = a.z + (size_t)row * DM + col; zr[0] = z0; zr[32] = z1; }
            else { const float mean = a.rowstat[2 * (size_t)row], rstd = a.rowstat[2 * (size_t)row + 1]; const float* zr = a.z + (size_t)row * DM + col;
                   const float h0 = (zr[0] - mean) * rstd * a.g1[col] + a.b1[col], h1 = (zr[32] - mean) * rstd * a.g1[col + 32] + a.b1[col + 32];
                   z0 = h0 * ALPHA + v0; z1 = h1 * ALPHA + v1; bf16* o = a.z2b + (size_t)row * DM + col; o[0] = (bf16)(pk2(z0, 0.f) & 0xFFFFu); o[32] = (bf16)(pk2(z1, 0.f) & 0xFFFFu); }
            float sm = z0 + z1, sq = z0 * z0 + z1 * z1;
#pragma unroll
            for (int o = 0; o < 1; ++o) { sm = pg8::add_xor16(row_sum16(sm)); sq = pg8::add_xor16(row_sum16(sq)); }
            if (r32 == 0) { float* sp = a.stats + ((size_t)row * 16 + ct) * 2; sp[0] = sm; sp[1] = sq; }
        }
    }
    __syncthreads();
}
template <int MODE> __device__ __forceinline__ void mini_phase(const MiniArgs& a, const Ctx& c, int nct, int G, int bx) {
#pragma unroll 1
    for (int t = bx; t < 8 * nct; t += G) mini_tile<MODE>(a, c, t / nct, t % nct);
}

#ifndef REP_P2
#define REP_P2 1
#endif
#ifndef REP_FOX
#define REP_FOX 1
#endif
#ifndef REP_DSA
#define REP_DSA 1
#endif
constexpr int LDS_BYTES = pg8::STAGE_BYTES;
__global__ void __launch_bounds__(512, 2) fox_dsa_fwd(KP p) {
    extern __shared__ __attribute__((aligned(16))) unsigned char lds_raw[];
    cg::grid_group grid = cg::this_grid();
#define MKCTX() Ctx c; { int t_ = threadIdx.x; asm volatile("" : "+v"(t_)); c.tid = t_; c.lane = t_ & 63; c.wid = __builtin_amdgcn_readfirstlane(t_ >> 6); c.gw = blockIdx.x * 8 + c.wid; c.ngw = gridDim.x * 8; c.lds = (LAS unsigned char*)lds_raw; } \
    const int G = gridDim.x, bx = blockIdx.x; unsigned char* ws = p.ws; (void)G; (void)bx; (void)ws;

    { MKCTX();
    p0_prologue(p, c);
    }
    grid.sync();
    { MKCTX();
    { pg8::Gemm g{(const pg8::bf16_t*)(ws + WS_XB), (const pg8::bf16_t*)(ws + WS_WIN), MT, NIN, DM}; pg8::StaticOrder S; S.init(MT, NIN, G, bx);
      pg8::EpiIn E{p.out, ws, p.b_forget};
      pg8::gemm_phase<pg8::EpiIn, pg8::StaticOrder, true, true>(c.lds, g, S, E); }
    }
    grid.sync();
    { MKCTX();
    if (c.gw < 24) cumsum_item(p, c.gw, c.lane);
    for (int vb = bx; vb < 256; vb += G) {
        { const int bh = vb >> 1, r0 = (vb & 1) * 2048 + c.wid * 256; unsigned* nd = (unsigned*)(ws + WS_NORM) + bh * 2;
          norm_rows((const bf16*)(ws + WS_FQ) + (size_t)(bh >> 3) * 4096 * 512, r0, 256, bh & 7, nd, c.lane);
          norm_rows((const bf16*)(ws + WS_FKP) + (size_t)(bh >> 3) * 4096 * 512, r0, 256, bh & 7, nd + 1, c.lane); }
        if (vb < 64) { const int sb = vb >> 3, h = vb & 7; unsigned* nd = (unsigned*)(ws + WS_NORM) + ((16 + sb) * 8 + h) * 2;
          norm_rows_f32(p.cfk + (size_t)sb * 4096 * 512, c.wid * 512, 512, h, nd + 1, c.lane);
          if (c.wid == 1) norm_rows((const bf16*)(ws + WS_FKA) + (size_t)sb * KVS * 512, 4096, 32, h, nd + 1, c.lane);
          if (c.wid == 0) norm_rows((const bf16*)(ws + WS_FQ) + (size_t)(MP + sb * 32) * 512, 0, 32, h, nd, c.lane); }
    }
    { float* scr = (float*)(ws + WS_SCR) + (size_t)bx * 32 * SCR_LD;
      for (int rep = 0; rep < REP_P2; ++rep) {
      unsigned* qctr = (unsigned*)(ws + WS_NORM) + 1024 - 2 - 2 * rep;
      volatile LAS int* qsh = (volatile LAS int*)(c.lds + 60000);
      for (;;) {
          if (c.tid == 0) *qsh = (int)atomicAdd(qctr, 1u);
          __syncthreads();
          int idx = *qsh;
          __syncthreads();
          if (idx >= 8 + 2048 + 640) break;
          if (idx >= 8 + 2048) { conv_item(p, c, idx - (8 + 2048)); continue; }
          int ub, uc, uh; if (idx < 8) { ub = idx; uc = -1; uh = 0; } else { idx -= 8; ub = (idx & 31) >> 1; uc = 63 - (idx >> 5); uh = idx & 1; }
          idx_unit(p, c, ub, uc, uh, scr);
      } } }
    }
    grid.sync();
    { MKCTX();
      for (int rep = 0; rep < REP_FOX; ++rep) {
      unsigned* qctr = (unsigned*)(ws + WS_NORM) + 1024 - 1 - 2 * rep;
      volatile LAS int* qsh = (volatile LAS int*)(c.lds + 60000);
      for (;;) {
          if (c.tid == 0) *qsh = (int)atomicAdd(qctr, 1u);
          __syncthreads();
          int idx = *qsh;
          __syncthreads();
          if (idx >= 80 + 16 * 256) break;
          if (idx < 16) { attn_dsa_s(p, c, idx >> 1, idx & 1); continue; }
          if (idx < 80) { idx -= 16; attn_fox_s(p, c, idx >> 3, idx & 7); continue; }
          idx -= 80;
          const int k = 15 - (idx >> 8), r = idx & 255;
          if (r < 32) attn_dsa_p(p, c, r >> 1, 4 * k + 3, r & 1);
          else if (r < 160) { const int u = r - 32; attn_fox_p(p, c, u >> 3, u & 7, k); }
          else { const int u = r - 160, lv = u >> 5, w = u & 31; attn_dsa_p(p, c, w >> 1, 4 * k + 2 - lv, w & 1); }
      } }
    }
    grid.sync();
    { MKCTX();
    { MiniArgs ma{}; ma.A = (const bf16*)(ws + WS_AO); ma.Bt = (const bf16*)(ws + WS_WO); ma.K = DM; ma.xs = p.xs; ma.z = (float*)(ws + WS_Z); ma.stats = (float*)(ws + WS_ST1);
      mini_phase<0>(ma, c, 16, G, bx); }
    { pg8::Gemm g{(const pg8::bf16_t*)(ws + WS_AO), (const pg8::bf16_t*)(ws + WS_WO), MP, DM, DM}; pg8::StaticOrder S; S.init(MP, DM, G, bx);
      pg8::EpiZ E{p.xp, p.xs, (float*)(ws + WS_Z), (float*)(ws + WS_ST1)};
      pg8::gemm_phase<pg8::EpiZ, pg8::StaticOrder, true, true>(c.lds, g, S, E); }
    }
    grid.sync();
    { MKCTX();
    ln1_apply(c, (const float*)(ws + WS_Z), (const float*)(ws + WS_ST1), p.ln1g, p.ln1b, (bf16*)(ws + WS_HB), (float*)(ws + WS_RS1));
    }
    grid.sync();
    { MKCTX();
    { MiniArgs ma{}; ma.A = (const bf16*)(ws + WS_HB); ma.Bt = (const bf16*)(ws + WS_WGU); ma.K = DM; ma.act = (bf16*)(ws + WS_ACT);
      mini_phase<1>(ma, c, 88, G, bx); }
    { pg8::Gemm g{(const pg8::bf16_t*)(ws + WS_HB), (const pg8::bf16_t*)(ws + WS_WGU), MP, NGU, DM}; pg8::StaticOrder S; S.init(MP, NGU, G, bx);
      pg8::EpiAct E{(pg8::bf16_t*)(ws + WS_ACT)};
      pg8::gemm_phase<pg8::EpiAct, pg8::StaticOrder, true, true>(c.lds, g, S, E); }
    }
    grid.sync();
    { MKCTX();
    { MiniArgs ma{}; ma.A = (const bf16*)(ws + WS_ACT); ma.Bt = (const bf16*)(ws + WS_WD); ma.K = DFF; ma.z = (float*)(ws + WS_Z); ma.stats = (float*)(ws + WS_ST2);
      ma.rowstat = (const float*)(ws + WS_RS1); ma.g1 = p.ln1g; ma.b1 = p.ln1b; ma.z2b = (bf16*)(ws + WS_Z2B);
      mini_phase<2>(ma, c, 16, G, bx); }
    { pg8::Gemm g{(const pg8::bf16_t*)(ws + WS_ACT), (const pg8::bf16_t*)(ws + WS_WD), MP, DM, DFF}; pg8::StaticOrder S; S.init(MP, DM, G, bx);
      pg8::EpiZ2 E{(const float*)(ws + WS_Z), (const float*)(ws + WS_RS1), p.ln1g, p.ln1b, (pg8::bf16_t*)(ws + WS_Z2B), (float*)(ws + WS_ST2)};
      pg8::gemm_phase<pg8::EpiZ2, pg8::StaticOrder, true, true>(c.lds, g, S, E); }
    }
    grid.sync();
    { MKCTX();
    ln2_apply(c, (const bf16*)(ws + WS_Z2B), (const float*)(ws + WS_ST2), p.ln2g, p.ln2b, p.out);
    }
}

extern "C" void kernel_launch(void* const* d_in, const int* in_sizes, int n_in, void* d_out, int out_size, void* d_ws, size_t ws_size, hipStream_t stream) {
    static int grid = 0;
    if (grid == 0) {
        if (n_in != 18 || (size_t)out_size != O_END || ws_size < WS_NEED) { fprintf(stderr, "kernel_launch: unexpected shapes (n_in %d out %d ws %zu need %zu)\n", n_in, out_size, ws_size, (size_t)WS_NEED); grid = -1; return; }
        int dev = 0, cus = 0, per_cu = 0;
        hipGetDevice(&dev); hipDeviceGetAttribute(&cus, hipDeviceAttributeMultiprocessorCount, dev);
        hipFuncSetAttribute((const void*)fox_dsa_fwd, hipFuncAttributeMaxDynamicSharedMemorySize, LDS_BYTES);
        if (hipOccupancyMaxActiveBlocksPerMultiprocessor(&per_cu, (const void*)fox_dsa_fwd, 512, LDS_BYTES) != hipSuccess || per_cu < 1) per_cu = 1;
        (void)hipGetLastError();
        grid = cus * 1;
        if (grid > 256) grid = 256;
    }
    if (grid < 0) return;
    KP p{};
    p.xp = (const float*)d_in[0]; p.xs = (const float*)d_in[1]; p.cfk = (const float*)d_in[2]; p.cfv = (const float*)d_in[3]; p.cflf = (const float*)d_in[4];
    p.cdk = (const float*)d_in[5]; p.cdv = (const float*)d_in[6]; p.cik = (const float*)d_in[7]; p.w_in = (const float*)d_in[8]; p.b_forget = (const float*)d_in[9];
    p.w_out = (const float*)d_in[10]; p.ln1g = (const float*)d_in[11]; p.ln1b = (const float*)d_in[12]; p.w_gate = (const float*)d_in[13]; p.w_up = (const float*)d_in[14];
    p.w_down = (const float*)d_in[15]; p.ln2g = (const float*)d_in[16]; p.ln2b = (const float*)d_in[17]; p.out = (float*)d_out; p.ws = (unsigned char*)d_ws;
    void* args[] = {&p};
    hipError_t e = hipLaunchCooperativeKernel((const void*)fox_dsa_fwd, dim3(grid), dim3(512), args, LDS_BYTES, stream);
    if (e != hipSuccess) fprintf(stderr, "cooperative launch failed: %s (grid %d)\n", hipGetErrorString(e), grid);
}
```

```cpp
#include <hip/hip_runtime.h>
#include <hip/hip_cooperative_groups.h>
#include <cstdio>
#include <cstdint>
namespace cg = cooperative_groups;

#define LAS __attribute__((address_space(3)))
typedef unsigned short bf16;
typedef short bf16x8 __attribute__((ext_vector_type(8)));
typedef float f32x4 __attribute__((ext_vector_type(4)));
typedef float f32x16 __attribute__((ext_vector_type(16)));
typedef unsigned u32x4 __attribute__((ext_vector_type(4)));
typedef unsigned u32x2 __attribute__((ext_vector_type(2)));
typedef short s16x4 __attribute__((ext_vector_type(4)));

constexpr int DM = 1024, SEQ = 4096, NBATCH = 16, MP = NBATCH * SEQ, DB = 8, DT = 32, MS = DB * DT, MT = MP + MS;
constexpr int KVS = 4160, NKEY_S = 4128;
constexpr int NIN = 2816, DFF = 2816, NGU = 5632;
constexpr int MW = 65;
constexpr int SCR_LD = 4160;
constexpr float ALPHA = 1.18920711500272f, LN_EPS = 1e-5f, LOG2E = 1.4426950408889634f, C2 = 0.125f * 1.4426950408889634f;

constexpr size_t O_YP = 0, O_YS = O_YP + (size_t)MP * DM, O_PFK = O_YS + (size_t)MS * DM, O_PFV = O_PFK + (size_t)MP * 512, O_PFLF = O_PFV + (size_t)MP * 512,
                 O_PDK = O_PFLF + (size_t)MP * 8, O_PDV = O_PDK + (size_t)MP * 128, O_PIK = O_PDV + (size_t)MP * 128, O_SFK = O_PIK + (size_t)MP * 64,
                 O_SFV = O_SFK + (size_t)MS * 512, O_SFLF = O_SFV + (size_t)MS * 512, O_SDK = O_SFLF + (size_t)MS * 8, O_SDV = O_SDK + (size_t)MS * 128,
                 O_SIK = O_SDV + (size_t)MS * 128, O_END = O_SIK + (size_t)MS * 64;
static_assert(O_END == 156321792, "d_out size");

constexpr size_t al256(size_t x) { return (x + 255) & ~(size_t)255; }
constexpr size_t WS_WIN = 0, WS_WO = WS_WIN + al256((size_t)NIN * DM * 2), WS_WGU = WS_WO + al256((size_t)DM * DM * 2), WS_WD = WS_WGU + al256((size_t)NGU * DM * 2),
                 WS_ROPE = WS_WD + al256((size_t)DM * DFF * 2), WS_XB = WS_ROPE + al256((size_t)NKEY_S * 16 * 4), WS_AO = WS_XB  ,
                 WS_FQ = WS_XB + al256((size_t)MT * DM * 2), WS_FKP = WS_FQ + al256((size_t)MT * 512 * 2), WS_FVP = WS_FKP + al256((size_t)MP * 512 * 2),
                 WS_FKA = WS_FVP + al256((size_t)MP * 512 * 2), WS_FVA = WS_FKA + al256((size_t)DB * KVS * 512 * 2), WS_DQ = WS_FVA + al256((size_t)DB * KVS * 512 * 2),
                 WS_DKP = WS_DQ + al256((size_t)MT * 512 * 2), WS_DVP = WS_DKP + al256((size_t)MP * 128 * 2), WS_DKA = WS_DVP + al256((size_t)MP * 128 * 2),
                 WS_DVA = WS_DKA + al256((size_t)DB * KVS * 128 * 2), WS_IQ = WS_DVA + al256((size_t)DB * KVS * 128 * 2), WS_IKP = WS_IQ + al256((size_t)MT * 256 * 2),
                 WS_IKA = WS_IKP + al256((size_t)MP * 64 * 2), WS_IW = WS_IKA + al256((size_t)DB * KVS * 64 * 2), WS_BIASP = WS_IW + al256((size_t)MT * 4 * 4),
                 WS_BIASS = WS_BIASP + al256((size_t)NBATCH * 8 * SEQ * 4), WS_NORM = WS_BIASS + al256((size_t)DB * 8 * KVS * 4), WS_SCR = WS_NORM + 4096  ,
                 WS_MASK = WS_SCR + al256((size_t)256 * 64 * SCR_LD * 4), WS_END1 = WS_MASK + al256((size_t)MT * MW * 8);
constexpr size_t WS_Z = WS_FQ, WS_HB = WS_Z + al256((size_t)MT * DM * 4), WS_ACT = WS_HB + al256((size_t)MT * DM * 2), WS_ST1 = WS_ACT + al256((size_t)MT * DFF * 2),
                 WS_ST2 = WS_ST1 + al256((size_t)MT * 16 * 8), WS_RS1 = WS_ST2 + al256((size_t)MT * 16 * 8), WS_END2 = WS_RS1 + al256((size_t)MT * 8);
constexpr size_t WS_Z2B = WS_XB;
constexpr size_t WS_NEED = WS_END1 > WS_END2 ? WS_END1 : WS_END2;
static_assert(WS_NEED <= (size_t)1073741824, "workspace map exceeds 4x the largest tensor");

struct KP {
    const float *xp, *xs, *cfk, *cfv, *cflf, *cdk, *cdv, *cik, *w_in, *b_forget, *w_out, *ln1g, *ln1b, *w_gate, *w_up, *w_down, *ln2g, *ln2b;
    float* out; unsigned char* ws;
};
namespace pg8 {
#define PG8_LAS __attribute__((address_space(3)))
typedef unsigned short bf16_t;
typedef short bf16x8 __attribute__((ext_vector_type(8)));
typedef float f32x4 __attribute__((ext_vector_type(4)));
typedef unsigned u32x4 __attribute__((ext_vector_type(4)));
constexpr int BM = 256, BK = 64, HALF = 128, HTB = HALF * BK * 2  , STAGE_BYTES = 8 * HTB, NXCD = 8, WGM = 8;

__host__ __device__ __forceinline__ int lds_byte(int r, int c) { const int st = (r >> 4) * 2 + (c >> 5), rr = r & 15, cc = c & 31, ob = rr * 64 + cc * 2; return st * 1024 + (ob ^ (((ob >> 9) & 1) << 5)); }
__host__ __device__ __forceinline__ void stage_rc(int b, int& R, int& C) { const int st = b / 1024, sb = b % 1024, swz = sb ^ (((sb >> 9) & 1) << 5); R = (st >> 1) * 16 + swz / 64; C = (st & 1) * 32 + (swz % 64) / 2; }
__host__ __device__ __forceinline__ int perm32(int rho) { const int n = rho >> 4, i = rho & 15; return 8 * (i >> 2) + 4 * n + (i & 3); }

struct Unit { int pm, pn; };
struct Gemm { const bf16_t* A; const bf16_t* Bt; int M, N, K; };

struct StaticOrder {
    int nM, nN, nwg, G, c;
    __host__ __device__ void init(int M, int N, int G_, int c_) { nM = M / BM; nN = N / BM; nwg = nM * nN; G = G_; c = c_; }
    __host__ __device__ bool next(int i, Unit& u) const {
        const long L = (long)i * G + c; if (L >= nwg) return false;
        int wgid = (int)L; { const int q = nwg / NXCD, r = nwg % NXCD, xcd = wgid % NXCD, off = wgid / NXCD; wgid = (xcd < r ? xcd * (q + 1) : r * (q + 1) + (xcd - r) * q) + off; }
        const int nig = WGM * nN, gid = wgid / nig, fm = gid * WGM, gsz = (nM - fm) < WGM ? (nM - fm) : WGM;
        u.pm = fm + ((wgid % nig) % gsz); u.pn = (wgid % nig) / gsz; return true;
    }
    __device__ __forceinline__ void a_ready(const Unit&) const {}
    __device__ __forceinline__ void done(const Unit&) const {}
};

__device__ __forceinline__ unsigned cvt_pk_bf16(float lo, float hi) { unsigned r; asm volatile("v_cvt_pk_bf16_f32 %0, %1, %2" : "=v"(r) : "v"(lo), "v"(hi)); return r; }
typedef float f32x2 __attribute__((ext_vector_type(2)));
__device__ __forceinline__ void st_bf16x8(bf16_t* p, f32x4 v0, f32x4 v1) { u32x4 w; w.x = cvt_pk_bf16(v0[0], v0[1]); w.y = cvt_pk_bf16(v0[2], v0[3]); w.z = cvt_pk_bf16(v1[0], v1[1]); w.w = cvt_pk_bf16(v1[2], v1[3]); *(u32x4*)p = w; }
__device__ __forceinline__ void st_f32x8(float* p, f32x4 v0, f32x4 v1) { *(f32x4*)p = v0; *(f32x4*)(p + 4) = v1; }
__device__ __forceinline__ void rope8(f32x4& v0, f32x4& v1, const float* tab, int fq) {
    f32x4 o0, o1; const bool oddrow = (fq & 1) != 0;
#pragma unroll
    for (int j = 0; j < 4; ++j) {
        { const unsigned u = __float_as_uint(v0[j]); auto rr = __builtin_amdgcn_permlane16_swap(u, u, false, false); o0[j] = __uint_as_float(oddrow ? rr[0] : rr[1]); }
        { const unsigned u = __float_as_uint(v1[j]); auto rr = __builtin_amdgcn_permlane16_swap(u, u, false, false); o1[j] = __uint_as_float(oddrow ? rr[0] : rr[1]); }
    }
    if (fq < 2) {
        const f32x4 c0 = *(const f32x4*)tab, c1 = *(const f32x4*)(tab + 4), s0 = *(const f32x4*)(tab + 8), s1 = *(const f32x4*)(tab + 12);
        if (fq == 0) { v0 = v0 * c0 - o0 * s0; v1 = v1 * c1 - o1 * s1; } else { v0 = v0 * c0 + o0 * s0; v1 = v1 * c1 + o1 * s1; }
    }
}
struct EpiIn {
    static constexpr bool PERM = true, AFTER_DRAIN = false;
    float* out; unsigned char* ws; const float* bforget;
    __device__ __forceinline__ void operator()(const f32x4 (&acc)[2][2][4][2], const Unit& u, int wr, int wc, int fr, int fq) const {
        const int pn = u.pn; const bool samp = (u.pm == MP / 256);
        const float* rope = (const float*)(ws + WS_ROPE);
#pragma unroll
        for (int ai = 0; ai < 2; ++ai)
#pragma unroll
            for (int m = 0; m < 4; ++m) {
                const int row = u.pm * 256 + ai * 128 + wr * 64 + m * 16 + fr;
                const int r2 = row - MP, sb = r2 >> 5, ss = r2 & 31;
                const int pos = samp ? (4096 + ss) : (row & 4095);
                const size_t arow = samp ? ((size_t)sb * KVS + 4096 + ss) : (size_t)row;
                const float* tab = rope + pos * 16;
#pragma unroll
                for (int bj = 0; bj < 2; ++bj) {
                    f32x4 v0 = acc[ai][bj][m][0], v1 = acc[ai][bj][m][1];
                    const int cit = bj * 128 + wc * 32 + fq * 8;
                    if (pn < 2) { st_bf16x8((bf16_t*)(ws + WS_FQ) + (size_t)row * 512 + pn * 256 + cit, v0 * C2, v1 * C2); }
                    else if (pn < 6) {
                        const bool isv = pn >= 4; const int col = (pn & 1) * 256 + cit;
                        float* fo = samp ? out + (isv ? O_SFV : O_SFK) + (size_t)r2 * 512 : out + (isv ? O_PFV : O_PFK) + (size_t)row * 512;
                        bf16_t* bo = (bf16_t*)(ws + (samp ? (isv ? WS_FVA : WS_FKA) : (isv ? WS_FVP : WS_FKP))) + arow * 512;
                        st_f32x8(fo + col, v0, v1); st_bf16x8(bo + col, v0, v1);
                    } else if (pn < 8) {
                        if ((wc & 1) == 0) rope8(v0, v1, tab, fq);
                        st_bf16x8((bf16_t*)(ws + WS_DQ) + (size_t)row * 512 + (pn - 6) * 256 + cit, v0 * C2, v1 * C2);
                    } else if (pn == 8) {
                        const bool isv = (bj == 1); const int col = cit - bj * 128;
                        if (!isv) { if ((wc & 1) == 0) rope8(v0, v1, tab, fq); }
                        float* fo = samp ? out + (isv ? O_SDV : O_SDK) + (size_t)r2 * 128 : out + (isv ? O_PDV : O_PDK) + (size_t)row * 128;
                        bf16_t* bo = (bf16_t*)(ws + (samp ? (isv ? WS_DVA : WS_DKA) : (isv ? WS_DVP : WS_DKP))) + arow * 128;
                        st_f32x8(fo + col, v0, v1); st_bf16x8(bo + col, v0, v1);
                    } else if (pn == 9) {
                        if ((wc & 1) == 0) rope8(v0, v1, tab, fq);
                        st_bf16x8((bf16_t*)(ws + WS_IQ) + (size_t)row * 256 + cit, v0, v1);
                    } else if (bj == 0) {
                        if (wc < 2) {
                            if (wc == 0) rope8(v0, v1, tab, fq);
                            float* fo = samp ? out + O_SIK + (size_t)r2 * 64 : out + O_PIK + (size_t)row * 64;
                            bf16_t* bo = (bf16_t*)(ws + (samp ? WS_IKA : WS_IKP)) + arow * 64;
                            st_f32x8(fo + cit, v0, v1); st_bf16x8(bo + cit, v0, v1);
                        } else if (wc == 2) {
                            if (fq == 0) {
                                const f32x4 b0 = *(const f32x4*)bforget, b1 = *(const f32x4*)(bforget + 4);
                                f32x4 z0 = v0 + b0, z1 = v1 + b1, l0, l1;
#pragma unroll
                                for (int j = 0; j < 4; ++j) { l0[j] = fminf(z0[j], 0.f) - log1pf(__expf(-fabsf(z0[j]))); l1[j] = fminf(z1[j], 0.f) - log1pf(__expf(-fabsf(z1[j]))); }
                                float* fo = samp ? out + O_SFLF + (size_t)r2 * 8 : out + O_PFLF + (size_t)row * 8;
                                st_f32x8(fo, l0, l1);
                            } else if (fq == 1) { *(f32x4*)((float*)(ws + WS_IW) + (size_t)row * 4) = v0; }
                        }
                    }
                }
            }
    }
};
__device__ __forceinline__ float add_xor16(float x) { const unsigned u = __builtin_bit_cast(unsigned, x); auto rr = __builtin_amdgcn_permlane16_swap(u, u, false, false); return __builtin_bit_cast(float, (unsigned)rr[0]) + __builtin_bit_cast(float, (unsigned)rr[1]); }
__device__ __forceinline__ float add_xor32(float x) { const unsigned u = __builtin_bit_cast(unsigned, x); auto rr = __builtin_amdgcn_permlane32_swap(u, u, false, false); return __builtin_bit_cast(float, (unsigned)rr[0]) + __builtin_bit_cast(float, (unsigned)rr[1]); }
struct EpiZ {
    static constexpr bool PERM = true, AFTER_DRAIN = false;
    const float* base_p; const float* base_s; float* zout; float* stats;
    __device__ __forceinline__ void operator()(const f32x4 (&acc)[2][2][4][2], const Unit& u, int wr, int wc, int fr, int fq) const {
        const bool samp = (u.pm == MP / 256);
#pragma unroll
        for (int ai = 0; ai < 2; ++ai)
#pragma unroll
            for (int m = 0; m < 4; ++m) {
                const int row = u.pm * 256 + ai * 128 + wr * 64 + m * 16 + fr;
                const float* bp = samp ? base_s + (size_t)(row - MP) * DM : base_p + (size_t)row * DM;
                float sm = 0.f, sq = 0.f;
#pragma unroll
                for (int bj = 0; bj < 2; ++bj) {
                    const int col = u.pn * 256 + bj * 128 + wc * 32 + fq * 8;
                    const f32x4 x0 = *(const f32x4*)(bp + col), x1 = *(const f32x4*)(bp + col + 4);
                    const f32x4 z0 = x0 * ALPHA + acc[ai][bj][m][0], z1 = x1 * ALPHA + acc[ai][bj][m][1];
                    st_f32x8(zout + (size_t)row * DM + col, z0, z1);
                    sm += (z0[0] + z0[1]) + (z0[2] + z0[3]) + (z1[0] + z1[1]) + (z1[2] + z1[3]);
                    sq += (z0[0] * z0[0] + z0[1] * z0[1]) + (z0[2] * z0[2] + z0[3] * z0[3]) + (z1[0] * z1[0] + z1[1] * z1[1]) + (z1[2] * z1[2] + z1[3] * z1[3]);
                }
                sm = add_xor32(add_xor16(sm)); sq = add_xor32(add_xor16(sq));
                if (fq == 0) { float* sp = stats + ((size_t)row * 16 + u.pn * 4 + wc) * 2; sp[0] = sm; sp[1] = sq; }
            }
    }
};
struct EpiZ2 {
    static constexpr bool PERM = true, AFTER_DRAIN = false;
    const float* z; const float* rowstat; const float* g1; const float* b1; bf16_t* z2b; float* stats;
    __device__ __forceinline__ void operator()(const f32x4 (&acc)[2][2][4][2], const Unit& u, int wr, int wc, int fr, int fq) const {
#pragma unroll
        for (int ai = 0; ai < 2; ++ai)
#pragma unroll
            for (int m = 0; m < 4; ++m) {
                const int row = u.pm * 256 + ai * 128 + wr * 64 + m * 16 + fr;
                const float mean = rowstat[2 * (size_t)row], rstd = rowstat[2 * (size_t)row + 1];
                float sm = 0.f, sq = 0.f;
#pragma unroll
                for (int bj = 0; bj < 2; ++bj) {
                    const int col = u.pn * 256 + bj * 128 + wc * 32 + fq * 8;
                    const float* zp = z + (size_t)row * DM + col;
                    const f32x4 x0 = *(const f32x4*)zp, x1 = *(const f32x4*)(zp + 4);
                    const f32x4 ga = *(const f32x4*)(g1 + col), gb = *(const f32x4*)(g1 + col + 4), ba = *(const f32x4*)(b1 + col), bb = *(const f32x4*)(b1 + col + 4);
                    const f32x4 h0 = (x0 - mean) * rstd * ga + ba, h1 = (x1 - mean) * rstd * gb + bb;
                    const f32x4 z0 = h0 * ALPHA + acc[ai][bj][m][0], z1 = h1 * ALPHA + acc[ai][bj][m][1];
                    st_bf16x8(z2b + (size_t)row * DM + col, z0, z1);
                    sm += (z0[0] + z0[1]) + (z0[2] + z0[3]) + (z1[0] + z1[1]) + (z1[2] + z1[3]);
                    sq += (z0[0] * z0[0] + z0[1] * z0[1]) + (z0[2] * z0[2] + z0[3] * z0[3]) + (z1[0] * z1[0] + z1[1] * z1[1]) + (z1[2] * z1[2] + z1[3] * z1[3]);
                }
                sm = add_xor32(add_xor16(sm)); sq = add_xor32(add_xor16(sq));
                if (fq == 0) { float* sp = stats + ((size_t)row * 16 + u.pn * 4 + wc) * 2; sp[0] = sm; sp[1] = sq; }
            }
    }
};
struct EpiAct {
    static constexpr bool PERM = true, AFTER_DRAIN = false;
    bf16_t* act;
    __device__ __forceinline__ void operator()(const f32x4 (&acc)[2][2][4][2], const Unit& u, int wr, int wc, int fr, int fq) const {
#pragma unroll
        for (int ai = 0; ai < 2; ++ai)
#pragma unroll
            for (int m = 0; m < 4; ++m) {
                const int row = u.pm * 256 + ai * 128 + wr * 64 + m * 16 + fr;
                f32x4 a0, a1;
#pragma unroll
                for (int j = 0; j < 4; ++j) {
                    const float g0 = acc[ai][0][m][0][j], g1 = acc[ai][0][m][1][j];
                    a0[j] = g0 * __builtin_amdgcn_rcpf(1.f + __expf(-g0)) * acc[ai][1][m][0][j];
                    a1[j] = g1 * __builtin_amdgcn_rcpf(1.f + __expf(-g1)) * acc[ai][1][m][1][j];
                }
                st_bf16x8(act + (size_t)row * DFF + u.pn * 128 + wc * 32 + fq * 8, a0, a1);
            }
    }
};
template <class Epi, class Sched, bool ALIGN_EPI = false, bool SP2 = false>
__device__ __forceinline__ void gemm_phase(PG8_LAS unsigned char* lds, const Gemm g, const Sched& S, const Epi& E) {
    int tid_ = threadIdx.x; asm volatile("" : "+v"(tid_));
    const int tid = tid_, wid = __builtin_amdgcn_readfirstlane(tid >> 6), lane = tid & 63, wr = wid >> 2, wc = wid & 3, fr = lane & 15, fq = lane >> 4;
    const int K = g.K, nt = K / BK;
    unsigned voffA[2], voffB[2];
#pragma unroll
    for (int i = 0; i < 2; ++i) { int R, C; stage_rc(tid * 16 + i * 8192, R, C); const int Rb = Epi::PERM ? ((R & ~31) + perm32(R & 31)) : R;
        voffA[i] = (unsigned)(R * K + C) * 2u; voffB[i] = (unsigned)(Rb * K + C) * 2u; }
    const size_t kstep = (size_t)(BK * 2);
    const size_t hstep = (size_t)HALF * K * 2;
    const size_t tstep = 2 * hstep;
    const unsigned ldsw = (unsigned)wid * 1024u;
    const int aoff = lds_byte(wr * 64 + fr, fq * 8), boff = lds_byte(wc * 32 + fr, fq * 8);
#define PG8_SA(b, h) (((b) * 2 + (h)) * HTB)
#define PG8_SB(b, h) ((4 + (b) * 2 + (h)) * HTB)
#define PG8_STAGE(bufoff, gbase, voff) do { _Pragma("unroll") for (int _i = 0; _i < 2; ++_i) \
        __builtin_amdgcn_global_load_lds((const unsigned*)((const char*)(gbase) + (voff)[_i]), (PG8_LAS unsigned*)(lds + (bufoff) + ldsw + _i * 8192), 16, 0, 0); } while (0)
#define PG8_LDA(dst, b, h) do { _Pragma("unroll") for (int m = 0; m < 4; ++m) _Pragma("unroll") for (int k = 0; k < 2; ++k) dst[m][k] = *(const PG8_LAS bf16x8*)(lds + PG8_SA(b, h) + aoff + m * 2048 + k * 1024); } while (0)
#define PG8_LDB(dst, b, h) do { _Pragma("unroll") for (int n = 0; n < 2; ++n) _Pragma("unroll") for (int k = 0; k < 2; ++k) dst[n][k] = *(const PG8_LAS bf16x8*)(lds + PG8_SB(b, h) + boff + n * 2048 + k * 1024); } while (0)
#define PG8_MMA(ai, bj, At, Bt) do { __builtin_amdgcn_s_setprio(1); _Pragma("unroll") for (int m = 0; m < 4; ++m) _Pragma("unroll") for (int n = 0; n < 2; ++n) _Pragma("unroll") for (int k = 0; k < 2; ++k) \
        acc[ai][bj][m][n] = __builtin_amdgcn_mfma_f32_16x16x32_bf16(Bt[n][k], At[m][k], acc[ai][bj][m][n], 0, 0, 0); __builtin_amdgcn_s_setprio(0); } while (0)
#define PG8_WAIT_V(n) asm volatile("s_waitcnt vmcnt(" #n ")" ::: "memory")
#define PG8_WAIT_L(n) asm volatile("s_waitcnt lgkmcnt(" #n ")" ::: "memory")
#define PG8_BAR __builtin_amdgcn_s_barrier()
#define PG8_SCHED __builtin_amdgcn_sched_barrier(0)
    Unit cur, nxt; int ui = 0;
    if (!S.next(0, cur)) return;
    f32x4 acc[2][2][4][2];
#pragma unroll
    for (int a = 0; a < 2; ++a)
#pragma unroll
        for (int b = 0; b < 2; ++b)
#pragma unroll
            for (int m = 0; m < 4; ++m)
#pragma unroll
                for (int n = 0; n < 2; ++n) acc[a][b][m][n] = (f32x4){0.f, 0.f, 0.f, 0.f};
    bf16x8 At[4][2], B0[2][2], B1[2][2];
    const char* cA = (const char*)g.A + (size_t)cur.pm * tstep; const char* cB = (const char*)g.Bt + (size_t)cur.pn * tstep;
    S.a_ready(cur);
    if constexpr (SP2) {
        PG8_STAGE(PG8_SB(0, 0), cB, voffB); PG8_STAGE(PG8_SB(0, 1), cB + hstep, voffB); PG8_STAGE(PG8_SA(0, 0), cA, voffA); PG8_STAGE(PG8_SA(0, 1), cA + hstep, voffA);
        if (wr == 1) PG8_BAR;
        PG8_WAIT_V(2); PG8_BAR;
        PG8_STAGE(PG8_SB(1, 0), cB + kstep, voffB); PG8_STAGE(PG8_SA(1, 0), cA + kstep, voffA); PG8_STAGE(PG8_SB(1, 1), cB + hstep + kstep, voffB);
        PG8_WAIT_V(6); PG8_BAR;
    } else {
        PG8_STAGE(PG8_SB(0, 0), cB, voffB); PG8_STAGE(PG8_SA(0, 0), cA, voffA); PG8_STAGE(PG8_SB(0, 1), cB + hstep, voffB); PG8_STAGE(PG8_SA(0, 1), cA + hstep, voffA);
        if (wr == 1) PG8_BAR;
        PG8_WAIT_V(4); PG8_BAR;
        PG8_STAGE(PG8_SB(1, 0), cB + kstep, voffB); PG8_STAGE(PG8_SA(1, 0), cA + kstep, voffA); PG8_STAGE(PG8_SB(1, 1), cB + hstep + kstep, voffB);
        PG8_WAIT_V(6); PG8_BAR;
    }
    for (;;) {
        const bool has_next = S.next(ui + 1, nxt);
        const char* nA = has_next ? (const char*)g.A + (size_t)nxt.pm * tstep : cA; const char* nB = has_next ? (const char*)g.Bt + (size_t)nxt.pn * tstep : cB;
        for (int t = 0; t < nt; t += 2) {
            const bool last = (t == nt - 2);
            const char* a1 = cA + (size_t)(t + 1) * kstep;
            const char* a2 = last ? nA : cA + (size_t)(t + 2) * kstep; const char* b2 = last ? nB : cB + (size_t)(t + 2) * kstep;
            const char* a3 = a2 + kstep; const char* b3 = b2 + kstep;
            if (last && has_next) S.a_ready(nxt);
            if constexpr (SP2) {
            PG8_LDB(B0, 0, 0); PG8_LDB(B1, 0, 1); PG8_SCHED; PG8_LDA(At, 0, 0); PG8_STAGE(PG8_SA(1, 1), a1 + hstep, voffA);
            PG8_WAIT_V(8); PG8_WAIT_L(0); PG8_BAR; PG8_MMA(0, 0, At, B0); PG8_MMA(0, 1, At, B1); PG8_BAR; PG8_SCHED;
            PG8_LDA(At, 0, 1); PG8_STAGE(PG8_SB(0, 0), b2, voffB); PG8_STAGE(PG8_SB(0, 1), b2 + hstep, voffB); PG8_STAGE(PG8_SA(0, 0), a2, voffA);
            PG8_WAIT_V(8); PG8_WAIT_L(0); PG8_BAR; PG8_MMA(1, 0, At, B0); PG8_MMA(1, 1, At, B1); PG8_BAR; PG8_SCHED;
            PG8_LDB(B0, 1, 0); PG8_LDB(B1, 1, 1); PG8_SCHED; PG8_LDA(At, 1, 0); PG8_STAGE(PG8_SA(0, 1), a2 + hstep, voffA);
            PG8_WAIT_V(8); PG8_WAIT_L(0); PG8_BAR; PG8_MMA(0, 0, At, B0); PG8_MMA(0, 1, At, B1); PG8_BAR; PG8_SCHED;
            PG8_LDA(At, 1, 1); PG8_STAGE(PG8_SB(1, 0), b3, voffB); PG8_STAGE(PG8_SB(1, 1), b3 + hstep, voffB); PG8_STAGE(PG8_SA(1, 0), a3, voffA);
            PG8_WAIT_V(8); PG8_WAIT_L(0); PG8_BAR; PG8_MMA(1, 0, At, B0); PG8_MMA(1, 1, At, B1); PG8_BAR; PG8_SCHED;
            } else {
            PG8_LDB(B0, 0, 0); PG8_SCHED; PG8_LDA(At, 0, 0); PG8_STAGE(PG8_SA(1, 1), a1 + hstep, voffA);
            PG8_WAIT_L(8); PG8_BAR; PG8_WAIT_L(0); PG8_MMA(0, 0, At, B0); PG8_BAR; PG8_SCHED;
            PG8_LDB(B1, 0, 1); PG8_STAGE(PG8_SB(0, 0), b2, voffB);
            PG8_BAR; PG8_WAIT_L(0); PG8_MMA(0, 1, At, B1); PG8_BAR;
            PG8_LDA(At, 0, 1); PG8_STAGE(PG8_SA(0, 0), a2, voffA);
            PG8_BAR; PG8_WAIT_L(0); PG8_MMA(1, 0, At, B0); PG8_BAR; PG8_SCHED;
            PG8_STAGE(PG8_SB(0, 1), b2 + hstep, voffB);
            PG8_WAIT_V(6); PG8_BAR; PG8_MMA(1, 1, At, B1); PG8_BAR;
            PG8_LDB(B0, 1, 0); PG8_SCHED; PG8_LDA(At, 1, 0); PG8_STAGE(PG8_SA(0, 1), a2 + hstep, voffA);
            PG8_WAIT_L(8); PG8_BAR; PG8_WAIT_L(0); PG8_MMA(0, 0, At, B0); PG8_BAR; PG8_SCHED;
            PG8_LDB(B1, 1, 1); PG8_STAGE(PG8_SB(1, 0), b3, voffB);
            PG8_BAR; PG8_WAIT_L(0); PG8_MMA(0, 1, At, B1); PG8_BAR;
            PG8_LDA(At, 1, 1); PG8_STAGE(PG8_SA(1, 0), a3, voffA);
            PG8_BAR; PG8_WAIT_L(0); PG8_MMA(1, 0, At, B0); PG8_BAR; PG8_SCHED;
            PG8_STAGE(PG8_SB(1, 1), b3 + hstep, voffB);
            PG8_WAIT_V(6); PG8_BAR; PG8_MMA(1, 1, At, B1); PG8_BAR;
            }
        }
        if constexpr (ALIGN_EPI) { if (wr == 0) PG8_BAR; }
        if constexpr (!Epi::AFTER_DRAIN) { E(acc, cur, wr, wc, fr, fq); S.done(cur); }
        if (!has_next) break;
#pragma unroll
        for (int a = 0; a < 2; ++a)
#pragma unroll
            for (int b = 0; b < 2; ++b)
#pragma unroll
                for (int m = 0; m < 4; ++m)
#pragma unroll
                    for (int n = 0; n < 2; ++n) acc[a][b][m][n] = (f32x4){0.f, 0.f, 0.f, 0.f};
        cur = nxt; cA = nA; cB = nB; ++ui;
        if constexpr (ALIGN_EPI) { if (wr == 1) PG8_BAR; }
    }
    PG8_WAIT_V(0);
    if constexpr (!ALIGN_EPI) { if (wr == 0) PG8_BAR; }
    PG8_BAR;
    if constexpr (Epi::AFTER_DRAIN) { E.fused(acc, cur, wr, wc, fr, fq, lds, wid, lane); S.done(cur); }
#undef PG8_SA
#undef PG8_SB
#undef PG8_STAGE
#undef PG8_LDA
#undef PG8_LDB
#undef PG8_MMA
#undef PG8_WAIT_V
#undef PG8_WAIT_L
#undef PG8_BAR
#undef PG8_SCHED
}
}
#ifndef REP_SEL
#define REP_SEL 1
#endif
#define LDS_WAIT() asm volatile("s_waitcnt lgkmcnt(0)" ::: "memory")
__device__ __forceinline__ unsigned pk2(float lo, float hi) { return pg8::cvt_pk_bf16(lo, hi); }
__device__ __forceinline__ float wave_sum(float v) {
#pragma unroll
    for (int o = 1; o < 64; o <<= 1) v += __shfl_xor(v, o);
    return v;
}
template <int CTRL> __device__ __forceinline__ int dpp_mov(int x) { return __builtin_amdgcn_update_dpp(x, x, CTRL, 0xF, 0xF, false); }
__device__ __forceinline__ float row_sum16(float x) {
    x += __int_as_float(dpp_mov<0xB1>(__float_as_int(x))); x += __int_as_float(dpp_mov<0x4E>(__float_as_int(x)));
    x += __int_as_float(dpp_mov<0x124>(__float_as_int(x))); x += __int_as_float(dpp_mov<0x128>(__float_as_int(x))); return x;
}
__device__ __forceinline__ unsigned row_max16(unsigned x) {
    unsigned y;
    y = (unsigned)dpp_mov<0xB1>((int)x); x = x > y ? x : y; y = (unsigned)dpp_mov<0x4E>((int)x); x = x > y ? x : y;
    y = (unsigned)dpp_mov<0x124>((int)x); x = x > y ? x : y; y = (unsigned)dpp_mov<0x128>((int)x); x = x > y ? x : y; return x;
}
struct Ctx { int tid, lane, wid, gw, ngw; LAS unsigned char* lds; };

__device__ __forceinline__ void transpose_item(const float* colp, int ldw, int k0, bf16* WT, int K, int dst_row0, LAS float* scr, int lane) {
#pragma unroll 8
    for (int i = 0; i < 32; ++i) { const int kk = 2 * i + (lane >> 5); scr[kk * 33 + (lane & 31)] = colp ? colp[(size_t)(k0 + kk) * ldw] : 0.f; }
    LDS_WAIT(); asm volatile("" ::: "memory");
    const int c = lane & 7;
#pragma unroll
    for (int j = 0; j < 4; ++j) { const int n = (lane >> 3) + 8 * j; const LAS float* s = scr + (8 * c) * 33 + n;
        u32x4 o; o.x = pk2(s[0 * 33], s[1 * 33]); o.y = pk2(s[2 * 33], s[3 * 33]); o.z = pk2(s[4 * 33], s[5 * 33]); o.w = pk2(s[6 * 33], s[7 * 33]);
        *(u32x4*)(WT + (size_t)(dst_row0 + n) * K + k0 + 8 * c) = o; }
    LDS_WAIT(); asm volatile("" ::: "memory");
}
__device__ __forceinline__ int win_src_col(int d) {
    if (d < 1536) return d;
    if (d < 2624) return d + 8;
    if (d < 2632) return 1536 + (d - 2624);
    if (d < 2636) return d;
    return -1;
}
__device__ __forceinline__ void cvt_copy(const Ctx& c, const float* src, bf16* dst, size_t n) {
    const size_t stride = (size_t)c.ngw * 64 * 8;
    for (size_t i = ((size_t)c.gw * 64 + c.lane) * 8; i < n; i += 4 * stride) {
        f32x4 a[4], b[4];
#pragma unroll
        for (int u = 0; u < 4; ++u) { const size_t j = i + u * stride; const size_t jc = j < n ? j : i; a[u] = *(const f32x4*)(src + jc); b[u] = *(const f32x4*)(src + jc + 4); }
#pragma unroll
        for (int u = 0; u < 4; ++u) { const size_t j = i + u * stride; if (j < n) {
            u32x4 o; o.x = pk2(a[u][0], a[u][1]); o.y = pk2(a[u][2], a[u][3]); o.z = pk2(b[u][0], b[u][1]); o.w = pk2(b[u][2], b[u][3]);
            *(u32x4*)(dst + j) = o; } }
    }
}
__device__ __forceinline__ void p0_prologue(const KP& p, const Ctx& c) {
    LAS float* scr = (LAS float*)(c.lds + c.wid * 16384);
    unsigned char* ws = p.ws;
    constexpr int I_IN = (NIN / 32) * 16, I_O = 32 * 16, I_GU = (NGU / 32) * 16, I_D = 32 * (DFF / 64);
    for (int it = c.gw; it < I_IN + I_O + I_GU + I_D; it += c.ngw) {
        int r = it; const int ln = c.lane & 31;
        if (r < I_IN) { const int nb = r >> 4, kb = r & 15; const int sc = win_src_col(32 * nb + ln);
            transpose_item(sc >= 0 ? p.w_in + sc : nullptr, 2636, 64 * kb, (bf16*)(ws + WS_WIN), DM, 32 * nb, scr, c.lane); continue; } r -= I_IN;
        if (r < I_O) { const int nb = r >> 4, kb = r & 15; transpose_item(p.w_out + 32 * nb + ln, DM, 64 * kb, (bf16*)(ws + WS_WO), DM, 32 * nb, scr, c.lane); continue; } r -= I_O;
        if (r < I_GU) { const int nb = r >> 4, kb = r & 15; const int d = 32 * nb + ln, pn = d >> 8, rr = d & 255;
            transpose_item(rr < 128 ? p.w_gate + 128 * pn + rr : p.w_up + 128 * pn + rr - 128, DFF, 64 * kb, (bf16*)(ws + WS_WGU), DM, 32 * nb, scr, c.lane); continue; } r -= I_GU;
        { const int nb = r / (DFF / 64), kb = r % (DFF / 64); transpose_item(p.w_down + 32 * nb + ln, DM, 64 * kb, (bf16*)(ws + WS_WD), DFF, 32 * nb, scr, c.lane); }
    }
    cvt_copy(c, p.xp, (bf16*)(ws + WS_XB), (size_t)MP * DM);
    cvt_copy(c, p.xs, (bf16*)(ws + WS_XB) + (size_t)MP * DM, (size_t)MS * DM);
    for (int b = 0; b < DB; ++b) {
        cvt_copy(c, p.cik + (size_t)b * 4096 * 64, (bf16*)(ws + WS_IKA) + (size_t)b * KVS * 64, (size_t)4096 * 64);
    }
    for (int g = c.gw * 64 + c.lane; g < DB * 32 * 160; g += c.ngw * 64) {
        const int b = g / (32 * 160), rr = (g / 160) & 31, pc = g % 160; const size_t rowi = (size_t)b * KVS + NKEY_S + rr; const u32x4 z = (u32x4){0u, 0u, 0u, 0u};
        if (pc < 64) *(u32x4*)((bf16*)(ws + WS_FKA) + rowi * 512 + pc * 8) = z;
        else if (pc < 128) *(u32x4*)((bf16*)(ws + WS_FVA) + rowi * 512 + (pc - 64) * 8) = z;
        else if (pc < 144) *(u32x4*)((bf16*)(ws + WS_DKA) + rowi * 128 + (pc - 128) * 8) = z;
        else *(u32x4*)((bf16*)(ws + WS_DVA) + rowi * 128 + (pc - 144) * 8) = z;
    }
    if (c.gw == 0) { for (int i = c.lane; i < 1024; i += 64) ((unsigned*)(ws + WS_NORM))[i] = 0u; }
    for (int g = c.gw * 64 + c.lane; g < NKEY_S * 8; g += c.ngw * 64) {
        const int pos = g >> 3, i = g & 7;
        const float invf = i == 0 ? 1.0f : i == 1 ? 0.1939227432012558f : i == 2 ? 0.03760603070259094f : i == 3 ? 0.007292664609849453f : i == 4 ? 0.0014142135623842478f
                         : i == 5 ? 0.00027424818836152554f : i == 6 ? 5.318296098266728e-05f : 1.0313386155758053e-05f;
        const float ang = (float)pos * invf;
        double t = (double)ang * 0.15915494309189535; t -= rint(t);
        const double q = rint(t * 4.0); const double r = (t - q * 0.25) * 6.283185307179586; const int qi = ((int)q) & 3;
        const double r2 = r * r;
        const double sn = r * (1.0 + r2 * (-1.0 / 6 + r2 * (1.0 / 120 + r2 * (-1.0 / 5040 + r2 * (1.0 / 362880 + r2 * (-1.0 / 39916800 + r2 * (1.0 / 6227020800.0)))))));
        const double cs = 1.0 + r2 * (-0.5 + r2 * (1.0 / 24 + r2 * (-1.0 / 720 + r2 * (1.0 / 40320 + r2 * (-1.0 / 3628800 + r2 * (1.0 / 479001600.0 + r2 * (-1.0 / 87178291200.0)))))));
        const double cc = qi == 0 ? cs : qi == 1 ? -sn : qi == 2 ? -cs : sn;
        const double ssn = qi == 0 ? sn : qi == 1 ? cs : qi == 2 ? -sn : -cs;
        float* tab = (float*)(ws + WS_ROPE) + pos * 16;
        tab[i] = (float)cc; tab[8 + i] = (float)ssn;
    }
}

__device__ __forceinline__ void cumsum_item(const KP& p, int item, int lane) {
    const bool samp = item >= 16; const int b = samp ? item - 16 : item; const int n = samp ? NKEY_S : SEQ;
    const float* src0 = samp ? p.cflf + (size_t)b * 4096 * 8 : p.out + O_PFLF + (size_t)b * 4096 * 8;
    const float* src1 = p.out + O_SFLF + (size_t)b * 32 * 8;
    float* dst = samp ? (float*)(p.ws + WS_BIASS) + (size_t)b * 8 * KVS : (float*)(p.ws + WS_BIASP) + (size_t)b * 8 * SEQ;
    const int ds = samp ? KVS : SEQ;
    float acc[8];
#pragma unroll
    for (int h = 0; h < 8; ++h) acc[h] = 0.f;
#pragma unroll 1
    for (int i0 = 0; i0 < 65; i0 += 13) {
        f32x4 a[13], bb[13];
#pragma unroll
        for (int i = 0; i < 13; ++i) { const int s0 = lane * 65 + i0 + i, s = s0 < n ? s0 : n - 1; const float* r = s < 4096 ? src0 + (size_t)s * 8 : src1 + (size_t)(s - 4096) * 8; a[i] = *(const f32x4*)r; bb[i] = *(const f32x4*)(r + 4); }
#pragma unroll
        for (int i = 0; i < 13; ++i) { const bool ok = lane * 65 + i0 + i < n;
#pragma unroll
            for (int h = 0; h < 4; ++h) { acc[h] += ok ? a[i][h] : 0.f; acc[4 + h] += ok ? bb[i][h] : 0.f; } }
    }
    float run[8];
#pragma unroll
    for (int h = 0; h < 8; ++h) { float v = acc[h];
#pragma unroll
        for (int o = 1; o < 64; o <<= 1) { const float t = __shfl_up(v, o); if (lane >= o) v += t; }
        run[h] = v - acc[h]; }
#pragma unroll 1
    for (int i0 = 0; i0 < 65; i0 += 13) {
        f32x4 a[13], bb[13];
#pragma unroll
        for (int i = 0; i < 13; ++i) { const int s0 = lane * 65 + i0 + i, s = s0 < n ? s0 : n - 1; const float* r = s < 4096 ? src0 + (size_t)s * 8 : src1 + (size_t)(s - 4096) * 8; a[i] = *(const f32x4*)r; bb[i] = *(const f32x4*)(r + 4); }
#pragma unroll
        for (int i = 0; i < 13; ++i) { const int s = lane * 65 + i0 + i; if (s < n) {
#pragma unroll
            for (int h = 0; h < 4; ++h) { run[h] += a[i][h]; run[4 + h] += bb[i][h]; dst[(size_t)h * ds + s] = -run[h] * LOG2E; dst[(size_t)(4 + h) * ds + s] = -run[4 + h] * LOG2E; } } }
    }
}

__device__ __forceinline__ void norm_rows(const bf16* base, int r0, int nrows, int h, unsigned* dst, int lane) {
    float mx = 0.f;
    const bf16* bp = base + (size_t)(r0 + (lane >> 3)) * 512 + h * 64 + (lane & 7) * 8;
    const int nit = (nrows + 7) >> 3;
    for (int it0 = 0; it0 < nit; it0 += 8) {
        u32x4 w[8];
#pragma unroll
        for (int k = 0; k < 8; ++k) { int it = it0 + k; const int rr = 8 * it + (lane >> 3); const int itc = (rr < nrows) ? it : 0; w[k] = *(const u32x4*)(bp + (size_t)itc * 8 * 512); }
#pragma unroll
        for (int k = 0; k < 8; ++k) {
            float ss = 0.f;
#pragma unroll
            for (int j = 0; j < 4; ++j) { const float lo = __uint_as_float(w[k][j] << 16), hi2 = __uint_as_float(w[k][j] & 0xFFFF0000u); ss += lo * lo + hi2 * hi2; }
            ss += __int_as_float(dpp_mov<0xB1>(__float_as_int(ss))); ss += __int_as_float(dpp_mov<0x4E>(__float_as_int(ss))); ss += __int_as_float(dpp_mov<0x124>(__float_as_int(ss)));
            mx = fmaxf(mx, (lane & 4) ? 0.f : ss);
        }
    }
    unsigned mu = row_max16(__float_as_uint(mx));
    { auto rr = __builtin_amdgcn_permlane16_swap(mu, mu, false, false); mu = rr[0] > rr[1] ? rr[0] : rr[1]; }
    { auto rr = __builtin_amdgcn_permlane32_swap(mu, mu, false, false); mu = rr[0] > rr[1] ? rr[0] : rr[1]; }
    if (lane == 0) atomicMax(dst, mu);
}
__device__ __forceinline__ void norm_rows_f32(const float* base, int r0, int nrows, int h, unsigned* dst, int lane) {
    float mx = 0.f;
    const float* bp = base + (size_t)(r0 + (lane >> 4)) * 512 + h * 64 + (lane & 15) * 4;
    const int nit = (nrows + 3) >> 2;
    for (int it0 = 0; it0 < nit; it0 += 8) {
        f32x4 w[8];
#pragma unroll
        for (int k = 0; k < 8; ++k) { const int it = it0 + k; const int rr = 4 * it + (lane >> 4); const int itc = (rr < nrows) ? it : 0; w[k] = *(const f32x4*)(bp + (size_t)itc * 4 * 512); }
#pragma unroll
        for (int k = 0; k < 8; ++k) { float ss = (w[k][0] * w[k][0] + w[k][1] * w[k][1]) + (w[k][2] * w[k][2] + w[k][3] * w[k][3]);
            ss = row_sum16(ss); mx = fmaxf(mx, ss); }
    }
    unsigned mu = __float_as_uint(mx);
    { auto rr = __builtin_amdgcn_permlane16_swap(mu, mu, false, false); mu = rr[0] > rr[1] ? rr[0] : rr[1]; }
    { auto rr = __builtin_amdgcn_permlane32_swap(mu, mu, false, false); mu = rr[0] > rr[1] ? rr[0] : rr[1]; }
    if (lane == 0) atomicMax(dst, mu);
}
__device__ __forceinline__ void conv_item(const KP& p, const Ctx& c, int j) {
    const int b = j / 80, r = j % 80;
    const float* src; bf16* dst; size_t off;
    if (r < 32) { src = p.cfk + (size_t)b * 4096 * 512; dst = (bf16*)(p.ws + WS_FKA) + (size_t)b * KVS * 512; off = (size_t)r * 65536; }
    else if (r < 64) { src = p.cfv + (size_t)b * 4096 * 512; dst = (bf16*)(p.ws + WS_FVA) + (size_t)b * KVS * 512; off = (size_t)(r - 32) * 65536; }
    else if (r < 72) { src = p.cdk + (size_t)b * 4096 * 128; dst = (bf16*)(p.ws + WS_DKA) + (size_t)b * KVS * 128; off = (size_t)(r - 64) * 65536; }
    else { src = p.cdv + (size_t)b * 4096 * 128; dst = (bf16*)(p.ws + WS_DVA) + (size_t)b * KVS * 128; off = (size_t)(r - 72) * 65536; }
    src += off + (size_t)c.tid * 8; dst += off + (size_t)c.tid * 8;
#pragma unroll 1
    for (int i0 = 0; i0 < 16; i0 += 4) {
        f32x4 a[4], bb[4];
#pragma unroll
        for (int u = 0; u < 4; ++u) { a[u] = *(const f32x4*)(src + (size_t)(i0 + u) * 4096); bb[u] = *(const f32x4*)(src + (size_t)(i0 + u) * 4096 + 4); }
#pragma unroll
        for (int u = 0; u < 4; ++u) { u32x4 o; o.x = pk2(a[u][0], a[u][1]); o.y = pk2(a[u][2], a[u][3]); o.z = pk2(bb[u][0], bb[u][1]); o.w = pk2(bb[u][2], bb[u][3]); *(u32x4*)(dst + (size_t)(i0 + u) * 4096) = o; }
    }
}
__device__ __forceinline__ unsigned f2key(float f) { const unsigned u = __float_as_uint(f); return (u & 0x80000000u) ? ~u : (u | 0x80000000u); }
__device__ __forceinline__ int crow(int r, int hi) { return (r & 3) + 8 * (r >> 2) + 4 * hi; }

__device__ __forceinline__ int count8_ge(unsigned mid, unsigned k0, unsigned k1, unsigned k2, unsigned k3, unsigned k4, unsigned k5, unsigned k6, unsigned k7) {
    unsigned long long m0, m1, m2, m3, m4, m5, m6, m7;
    asm("v_cmp_le_u32_e64 %0, %8, %9\n\tv_cmp_le_u32_e64 %1, %8, %10\n\tv_cmp_le_u32_e64 %2, %8, %11\n\tv_cmp_le_u32_e64 %3, %8, %12\n\t"
        "v_cmp_le_u32_e64 %4, %8, %13\n\tv_cmp_le_u32_e64 %5, %8, %14\n\tv_cmp_le_u32_e64 %6, %8, %15\n\tv_cmp_le_u32_e64 %7, %8, %16"
        : "=&s"(m0), "=&s"(m1), "=&s"(m2), "=&s"(m3), "=&s"(m4), "=&s"(m5), "=&s"(m6), "=&s"(m7)
        : "s"(mid), "v"(k0), "v"(k1), "v"(k2), "v"(k3), "v"(k4), "v"(k5), "v"(k6), "v"(k7));
    return (__popcll(m0) + __popcll(m1)) + (__popcll(m2) + __popcll(m3)) + ((__popcll(m4) + __popcll(m5)) + (__popcll(m6) + __popcll(m7)));
}
template <int L0> __device__ __forceinline__ void words8_ge(unsigned t, int& wlo, int& whi, unsigned k0, unsigned k1, unsigned k2, unsigned k3, unsigned k4, unsigned k5, unsigned k6, unsigned k7) {
    unsigned long long m0, m1, m2, m3, m4, m5, m6, m7;
    asm volatile("v_cmp_le_u32_e64 %0, %8, %9\n\tv_cmp_le_u32_e64 %1, %8, %10\n\tv_cmp_le_u32_e64 %2, %8, %11\n\tv_cmp_le_u32_e64 %3, %8, %12\n\t"
        "v_cmp_le_u32_e64 %4, %8, %13\n\tv_cmp_le_u32_e64 %5, %8, %14\n\tv_cmp_le_u32_e64 %6, %8, %15\n\tv_cmp_le_u32_e64 %7, %8, %16"
        : "=&s"(m0), "=&s"(m1), "=&s"(m2), "=&s"(m3), "=&s"(m4), "=&s"(m5), "=&s"(m6), "=&s"(m7)
        : "s"(t), "v"(k0), "v"(k1), "v"(k2), "v"(k3), "v"(k4), "v"(k5), "v"(k6), "v"(k7));
#define WL_(m, L) asm volatile("v_writelane_b32 %0, %2, %4\n\tv_writelane_b32 %1, %3, %4" : "+v"(wlo), "+v"(whi) : "s"((int)(unsigned)(m)), "s"((int)(unsigned)((m) >> 32)), "n"(L))
    WL_(m0, L0); WL_(m1, L0 + 1); WL_(m2, L0 + 2); WL_(m3, L0 + 3); WL_(m4, L0 + 4); WL_(m5, L0 + 5); WL_(m6, L0 + 6); WL_(m7, L0 + 7);
#undef WL_
}
__device__ __forceinline__ void load_row(float (&v)[65], const float* row, int N, int lane) {
    const float* r0 = row + lane; asm volatile("" : "+v"(r0));
    const __attribute__((address_space(1))) float* r = (const __attribute__((address_space(1))) float*)r0;
#pragma unroll
    for (int j = 0; j < 8; ++j) if (512 * j < N) {
#pragma unroll
        for (int i = 8 * j; i < 8 * j + 8; ++i) v[i] = r[64 * i];
    }
    if (N > 4096) v[64] = r[4096];
}
__device__ __forceinline__ void keys_from_row(unsigned (&key)[65], const float (&v)[65], int N, int lane) {
#pragma unroll
    for (int j = 0; j < 8; ++j) {
        if (512 * j < N) {
#pragma unroll
            for (int i = 8 * j; i < 8 * j + 8; ++i) key[i] = f2key(v[i]);
        } else {
#pragma unroll
            for (int i = 8 * j; i < 8 * j + 8; ++i) key[i] = 0u;
        }
    }
    key[64] = (N > 4096 && lane < N - 4096) ? f2key(v[64]) : 0u;
}
__device__ __forceinline__ void select_query(const unsigned (&key)[65], int N, unsigned long long* mrow, LAS unsigned long long* lw, int lane) {
    if (N <= 256) { mrow[lane] = (64 * lane < N) ? ~0ull : 0ull; return; }
    unsigned lo = 0u, hi = 0xFFFFFFFFu; int clo = N; bool exact = false;
    {
        unsigned mk = 0u;
#pragma unroll
        for (int j = 0; j < 8; ++j) if (512 * j < N) {
#pragma unroll
            for (int i = 8 * j; i < 8 * j + 8; ++i) mk = mk > key[i] ? mk : key[i];
        }
        mk = mk > key[64] ? mk : key[64];
        { auto rr = __builtin_amdgcn_permlane32_swap(mk, mk, false, false); mk = rr[0] > rr[1] ? rr[0] : rr[1]; }
        { auto rr = __builtin_amdgcn_permlane16_swap(mk, mk, false, false); mk = rr[0] > rr[1] ? rr[0] : rr[1]; }
        mk = row_max16(mk);
        mk = (unsigned)__builtin_amdgcn_readfirstlane((int)mk);
        if (mk != 0xFFFFFFFFu) hi = mk + 1u;
        if (mk >= 0x80000000u + (6u << 23)) {
            const unsigned lc = mk - (6u << 23); int cnt = 0;
#pragma unroll
            for (int j = 0; j < 8; ++j) if (512 * j < N) cnt += count8_ge(lc, key[8 * j], key[8 * j + 1], key[8 * j + 2], key[8 * j + 3], key[8 * j + 4], key[8 * j + 5], key[8 * j + 6], key[8 * j + 7]);
            if (N > 4096) cnt += __popcll(__ballot(key[64] >= lc));
            if (cnt >= 256) { lo = lc; clo = cnt; exact = (cnt == 256); }
        }
    }
    if (!exact) {
        int chi = 0; bool bis = false;
        for (;;) {
            const unsigned span = hi - lo;
            if (span <= 1u) break;
            unsigned mid = lo + (span >> 1);
            if (!bis && lo >= 0x80000000u) {
                const float lv = __uint_as_float(lo & 0x7FFFFFFFu), hv = __uint_as_float(hi & 0x7FFFFFFFu);
                const float lc = __log2f((float)clo), lh = __log2f(chi > 0 ? (float)chi : 0.5f);
                const float f = (lc - 8.0f) / (lc - lh);
                const unsigned g = __float_as_uint(lv + (hv - lv) * f) | 0x80000000u;
                mid = g <= lo ? lo + 1u : (g >= hi ? hi - 1u : g);
            }
            bis = !bis;
            int cnt = 0;
#pragma unroll
            for (int j = 0; j < 8; ++j) if (512 * j < N) cnt += count8_ge(mid, key[8 * j], key[8 * j + 1], key[8 * j + 2], key[8 * j + 3], key[8 * j + 4], key[8 * j + 5], key[8 * j + 6], key[8 * j + 7]);
            if (N > 4096) cnt += __popcll(__ballot(key[64] >= mid));
            if (cnt >= 256) { lo = mid; clo = cnt; if (cnt == 256) { exact = true; break; } } else { hi = mid; chi = cnt; }
        }
    }
    if (exact) {
        int wlo = 0, whi = 0;
#define W8_(j) if (512 * (j) < N) words8_ge<8 * (j)>(lo, wlo, whi, key[8 * (j)], key[8 * (j) + 1], key[8 * (j) + 2], key[8 * (j) + 3], key[8 * (j) + 4], key[8 * (j) + 5], key[8 * (j) + 6], key[8 * (j) + 7]);
        W8_(0) W8_(1) W8_(2) W8_(3) W8_(4) W8_(5) W8_(6) W8_(7)
#undef W8_
        mrow[lane] = ((unsigned long long)(unsigned)whi << 32) | (unsigned)wlo;
        if (N > 4096) { const unsigned long long w = __ballot(key[64] >= lo); if (lane == 0) mrow[64] = w; }
        return;
    } else {
        int cgt = 0;
#pragma unroll
        for (int j = 0; j < 9; ++j) if (512 * j < N) {
#pragma unroll
            for (int i = 8 * j; i < 8 * j + 8 && i < 65; ++i) cgt += __popcll(__ballot(key[i] > lo));
        }
        const int need = 256 - cgt; int taken = 0; const unsigned long long lt = (1ull << lane) - 1ull;
#pragma unroll
        for (int j = 0; j < 9; ++j) if (512 * j < N) {
#pragma unroll
            for (int i = 8 * j; i < 8 * j + 8 && i < 65; ++i) {
                const bool gt = key[i] > lo, eq = key[i] == lo;
                const unsigned long long tb = __ballot(eq);
                const int rank = taken + __popcll(tb & lt);
                const bool sel = gt || (eq && rank < need);
                taken += __popcll(tb);
                const unsigned long long w = __ballot(sel);
                if (lane == 0) lw[i] = w;
            }
        }
    }
    (void)clo;
    LDS_WAIT();
    const int nw = (N + 63) >> 6;
    if (lane < nw) mrow[lane] = lw[lane];
    if (lane == 0 && nw > 64) mrow[64] = lw[64];
    LDS_WAIT();
}

__device__ __forceinline__ void idx_unit(const KP& p, const Ctx& c, int b, int ch, int half, float* scr) {
    const int lane = c.lane, wid = c.wid, r32 = lane & 31, hi = lane >> 5;
    const bool samp = ch < 0;
    const int N = samp ? NKEY_S : 64 * (ch + 1);
    const size_t qrow0 = samp ? (size_t)MP + b * 32 : (size_t)b * 4096 + 64 * ch + 32 * half;
    const bf16* ikb = samp ? (const bf16*)(p.ws + WS_IKA) + (size_t)b * KVS * 64 : (const bf16*)(p.ws + WS_IKP) + (size_t)b * 4096 * 64;
    const int nst = N / 32;
    {
        bf16x8 qf[4][4]; const bf16* qp = (const bf16*)(p.ws + WS_IQ) + (qrow0 + r32) * 256 + hi * 8;
#pragma unroll
        for (int h = 0; h < 4; ++h)
#pragma unroll
            for (int ks = 0; ks < 4; ++ks) qf[h][ks] = *(const bf16x8*)(qp + h * 64 + ks * 16);
        f32x4 wq[16];
#pragma unroll
        for (int r = 0; r < 16; ++r) wq[r] = *(const f32x4*)((const float*)(p.ws + WS_IW) + (qrow0 + crow(r, hi)) * 4);
        bf16x8 a[4];
        if (wid < nst) { const bf16* kp = ikb + (size_t)(32 * wid + r32) * 64 + hi * 8;
#pragma unroll
          for (int ks = 0; ks < 4; ++ks) a[ks] = *(const bf16x8*)(kp + ks * 16); }
        for (int st = wid; st < nst; st += 8) {
            bf16x8 an[4];
            if (st + 8 < nst) { const bf16* kp = ikb + (size_t)(32 * (st + 8) + r32) * 64 + hi * 8;
#pragma unroll
                for (int ks = 0; ks < 4; ++ks) an[ks] = *(const bf16x8*)(kp + ks * 16); }
            f32x16 sc;
#pragma unroll
            for (int r = 0; r < 16; ++r) sc[r] = 0.f;
#pragma unroll
            for (int h = 0; h < 4; ++h) { f32x16 d;
#pragma unroll
                for (int r = 0; r < 16; ++r) d[r] = 0.f;
#pragma unroll
                for (int ks = 0; ks < 4; ++ks) d = __builtin_amdgcn_mfma_f32_32x32x16_bf16(qf[h][ks], a[ks], d, 0, 0, 0);
#pragma unroll
                for (int r = 0; r < 16; ++r) sc[r] += wq[r][h] * (d[r] > 0.f ? d[r] : 0.f); }
            float* sp = scr + (size_t)(4 * hi) * SCR_LD + 32 * st + r32;
#pragma unroll
            for (int r = 0; r < 16; ++r) sp[(size_t)((r & 3) + 8 * (r >> 2)) * SCR_LD] = sc[r];
            if (st + 8 < nst) {
#pragma unroll
                for (int ks = 0; ks < 4; ++ks) a[ks] = an[ks]; }
        }
    }
    if (N < 4096 && (N & 511)) {
        const int pad = 512 - (N & 511);
        for (int rr = wid; rr < 32; rr += 8) for (int kk = lane; kk < pad; kk += 64) scr[(size_t)rr * SCR_LD + N + kk] = -INFINITY;
    }
    __syncthreads();
    {
        float v[65];
        load_row(v, scr + (size_t)wid * SCR_LD, N, lane);
#pragma unroll 1
        for (int q = wid; q < 32; q += 8) {
            unsigned key[65];
            keys_from_row(key, v, N, lane);
            if (q + 8 < 32) load_row(v, scr + (size_t)(q + 8) * SCR_LD, N, lane);
            select_query(key, N, (unsigned long long*)(p.ws + WS_MASK) + (qrow0 + q) * MW, (LAS unsigned long long*)(c.lds + wid * 1024), lane);
        }
    }
    __syncthreads();
}

struct FU {
    const bf16* q; const bf16* kbase; const bf16* vbase; const float* bias; const unsigned long long* mask; bf16* o;
    int kvstride, ntiles, qpos, causal_from, wave_qmax, t_begin; bool valid;
};
constexpr int FT_ROW = 144, FT_VROW = 192  , FT_V = 64 * FT_ROW, FT_BIAS = FT_V + 64 * FT_VROW, FT_BUF = FT_BIAS + 256;
__device__ __forceinline__ s16x4 vtr(const LAS unsigned char* p) { return __builtin_bit_cast(s16x4, __builtin_amdgcn_ds_read_tr16_b64_v4i16((LAS s16x4*)p)); }

constexpr float FOX_THR = 24.f;
__device__ __forceinline__ float vmax3(float a, float b, float c) { float r; asm("v_max3_f32 %0, %1, %2, %3" : "=v"(r) : "v"(a), "v"(b), "v"(c)); return r; }
__device__ __forceinline__ float vmax2(float a, float b) { float r; asm("v_max_f32_e32 %0, %1, %2" : "=v"(r) : "v"(a), "v"(b)); return r; }
template <int BP> __device__ __forceinline__ unsigned bitmask1(int w) { int r; asm("v_bfe_i32 %0, %1, %2, 1" : "=v"(r) : "v"(w), "n"(BP)); return (unsigned)r; }
__device__ __forceinline__ void flash_tile(const FU& u, const LAS unsigned char* Kb, int t, unsigned long long mw, const bf16x8 (&qr)[4], float& m, f32x16& negm, float& l, f32x16& o0, f32x16& o1, int r32, int hi, int vlane) {
            const LAS unsigned char* Vb = Kb + FT_V;
            f32x16 c0, c1;
            if (u.bias) { const LAS float* bl = (const LAS float*)(Kb + FT_BIAS);
#pragma unroll
                for (int g = 0; g < 4; ++g) { const f32x4 t0 = *(const LAS f32x4*)(bl + 8 * g + 4 * hi), t1 = *(const LAS f32x4*)(bl + 32 + 8 * g + 4 * hi);
#pragma unroll
                    for (int j = 0; j < 4; ++j) { c0[4 * g + j] = t0[j] - m; c1[4 * g + j] = t1[j] - m; } }
            } else { c0 = negm; c1 = negm; }
#pragma unroll
            for (int ks = 0; ks < 4; ++ks) {
                const bf16x8 a0 = *(const LAS bf16x8*)(Kb + r32 * FT_ROW + ks * 32 + hi * 16), a1 = *(const LAS bf16x8*)(Kb + (32 + r32) * FT_ROW + ks * 32 + hi * 16);
                c0 = __builtin_amdgcn_mfma_f32_32x32x16_bf16(a0, qr[ks], c0, 0, 0, 0); c1 = __builtin_amdgcn_mfma_f32_32x32x16_bf16(a1, qr[ks], c1, 0, 0, 0);
            }
            if (t >= u.causal_from) { const int kb = 64 * t + 4 * hi;
#pragma unroll
                for (int r = 0; r < 16; ++r) { const int kv = kb + (r & 3) + 8 * (r >> 2); if (kv > u.qpos) c0[r] = -INFINITY; if (kv + 32 > u.qpos) c1[r] = -INFINITY; } }
            asm volatile("s_nop 15\n\ts_nop 7" : "+v"(c0), "+v"(c1));
            float ma = vmax3(c0[0], c0[1], c1[0]), mb = vmax3(c0[2], c0[3], c1[1]); ma = vmax3(ma, c1[2], c1[3]);
#pragma unroll
            for (int r = 4; r < 16; r += 4) { ma = vmax3(ma, c0[r], c0[r + 1]); mb = vmax3(mb, c0[r + 2], c0[r + 3]); ma = vmax3(ma, c1[r], c1[r + 1]); mb = vmax3(mb, c1[r + 2], c1[r + 3]); }
            float mx = vmax2(ma, mb); { auto rr = __builtin_amdgcn_permlane32_swap(__float_as_uint(mx), __float_as_uint(mx), false, false); mx = vmax2(__uint_as_float(rr[0]), __uint_as_float(rr[1])); }
            if (u.bias && !__any(mx > -FOX_THR)) return;
            if (__any(mx > 16.f)) {
                const float dl = vmax2(mx, 0.f), al = __builtin_amdgcn_exp2f(-dl); m += dl; l *= al;
#pragma unroll
                for (int r = 0; r < 16; ++r) { o0[r] *= al; o1[r] *= al; c0[r] -= dl; c1[r] -= dl; negm[r] = -m; }
            }
#pragma unroll
            for (int r = 0; r < 16; ++r) { c0[r] = __builtin_amdgcn_exp2f(c0[r]); c1[r] = __builtin_amdgcn_exp2f(c1[r]); }
            if (u.mask) {
                const int lo = (int)((unsigned)mw >> (4 * hi)), hw = (int)((unsigned)(mw >> 32) >> (4 * hi));
#define MK(r) { c0[r] = __uint_as_float(__float_as_uint(c0[r]) & bitmask1<((r) & 3) + 8 * ((r) >> 2)>(lo)); c1[r] = __uint_as_float(__float_as_uint(c1[r]) & bitmask1<((r) & 3) + 8 * ((r) >> 2)>(hw)); }
                MK(0) MK(1) MK(2) MK(3) MK(4) MK(5) MK(6) MK(7) MK(8) MK(9) MK(10) MK(11) MK(12) MK(13) MK(14) MK(15)
#undef MK
            }
            float ps = 0.f;
#pragma unroll
            for (int r = 0; r < 16; ++r) ps += c0[r] + c1[r];
            l += ps;
            bf16x8 pf[4];
#pragma unroll
            for (int s = 0; s < 2; ++s) {
                u32x4 w0, w1;
                w0.x = pk2(c0[8 * s + 0], c0[8 * s + 1]); w0.y = pk2(c0[8 * s + 2], c0[8 * s + 3]); w0.z = pk2(c0[8 * s + 4], c0[8 * s + 5]); w0.w = pk2(c0[8 * s + 6], c0[8 * s + 7]);
                w1.x = pk2(c1[8 * s + 0], c1[8 * s + 1]); w1.y = pk2(c1[8 * s + 2], c1[8 * s + 3]); w1.z = pk2(c1[8 * s + 4], c1[8 * s + 5]); w1.w = pk2(c1[8 * s + 6], c1[8 * s + 7]);
                pf[s] = __builtin_bit_cast(bf16x8, w0); pf[2 + s] = __builtin_bit_cast(bf16x8, w1);
            }
            const LAS unsigned char* vp = Vb + vlane;
#pragma unroll
            for (int s = 0; s < 4; ++s) {
                const s16x4 a_lo0 = vtr(vp + (16 * s) * FT_VROW), a_hi0 = vtr(vp + (16 * s + 8) * FT_VROW);
                const s16x4 a_lo1 = vtr(vp + (16 * s) * FT_VROW + 64), a_hi1 = vtr(vp + (16 * s + 8) * FT_VROW + 64);
                const bf16x8 A0 = (bf16x8){a_lo0[0], a_lo0[1], a_lo0[2], a_lo0[3], a_hi0[0], a_hi0[1], a_hi0[2], a_hi0[3]};
                const bf16x8 A1 = (bf16x8){a_lo1[0], a_lo1[1], a_lo1[2], a_lo1[3], a_hi1[0], a_hi1[1], a_hi1[2], a_hi1[3]};
                o0 = __builtin_amdgcn_mfma_f32_32x32x16_bf16(A0, pf[s], o0, 0, 0, 0); o1 = __builtin_amdgcn_mfma_f32_32x32x16_bf16(A1, pf[s], o1, 0, 0, 0);
            }
}
__device__ __forceinline__ void flash_unit(const FU& u, const Ctx& c) {
    const int tid = c.tid, lane = c.lane, r32 = lane & 31, hi = lane >> 5;
    LAS unsigned char* lds = c.lds;
    const int lrow = tid >> 3, lch = tid & 7;
    const bf16* kg = u.kbase + (size_t)lrow * u.kvstride + lch * 8;
    const bf16* vg = u.vbase + (size_t)lrow * u.kvstride + lch * 8;
    const size_t tstep = (size_t)64 * u.kvstride;
    const int loff = lrow * FT_ROW + lch * 16, loffv = lrow * FT_VROW + lch * 16;
    const int t0 = u.t_begin, tl = u.ntiles - 1, n = tl - t0 + 1;
    u32x4 kA, vA, kB, vB; float bA = 0.f, bB = 0.f; unsigned long long mA = 0ull, mB = 0ull, mC = 0ull;
#define FL_BAR() asm volatile("s_waitcnt lgkmcnt(0)\n\ts_barrier" ::: "memory")
#define FL_LOAD(S, tt) do { k##S = *(const u32x4*)(kg + (size_t)(tt) * tstep); v##S = *(const u32x4*)(vg + (size_t)(tt) * tstep); if (u.bias) b##S = u.bias[(tt) * 64 + (tid & 63)]; if (u.mask) m##S = u.mask[tt]; } while (0)
#define FL_STORE(bufi, S) do { LAS unsigned char* nb_ = lds + (bufi) * FT_BUF; *(LAS u32x4*)(nb_ + loff) = k##S; *(LAS u32x4*)(nb_ + FT_V + loffv) = v##S; if (tid < 64) *(LAS float*)(nb_ + FT_BIAS + tid * 4) = b##S; } while (0)
    FL_LOAD(A, tl); FL_LOAD(B, (tl - 1 > t0 ? tl - 1 : t0));
    bf16x8 qr[4];
    if (u.valid) {
#pragma unroll
        for (int ks = 0; ks < 4; ++ks) qr[ks] = *(const bf16x8*)(u.q + ks * 16 + hi * 8);
    }
    FL_STORE(0, A); FL_STORE(1, B); mC = mA; unsigned long long mD = mB;
    float m = 0.f, l = 0.f; f32x16 o0, o1, negm;
#pragma unroll
    for (int r = 0; r < 16; ++r) { o0[r] = 0.f; o1[r] = 0.f; negm[r] = 0.f; }
    const int vlane = (4 * hi + ((lane & 15) >> 2)) * FT_VROW + (16 * ((lane >> 4) & 1) + 4 * (lane & 3)) * 2;
    FL_BAR();
    for (int i = 0; i < n; i += 2) {
        const int ta = tl - i, tb = tl - i - 1;
        { const int tn = tl - i - 2, tm = tl - i - 3; FL_LOAD(A, (tn > t0 ? tn : t0)); FL_LOAD(B, (tm > t0 ? tm : t0)); }
        if (u.valid && !(ta >= u.causal_from && 64 * ta > u.wave_qmax)) flash_tile(u, lds, ta, mC, qr, m, negm, l, o0, o1, r32, hi, vlane);
        if (tb >= t0 && u.valid && !(tb >= u.causal_from && 64 * tb > u.wave_qmax)) flash_tile(u, lds + FT_BUF, tb, mD, qr, m, negm, l, o0, o1, r32, hi, vlane);
        FL_BAR();
        FL_STORE(0, A); FL_STORE(1, B); mC = mA; mD = mB;
        FL_BAR();
    }
#undef FL_LOAD
#undef FL_BAR
#undef FL_STORE
    if (u.valid) {
        l = pg8::add_xor32(l); const float inv = 1.0f / l;
#pragma unroll
        for (int g = 0; g < 4; ++g) {
            u32x2 w0, w1;
            w0.x = pk2(o0[4 * g] * inv, o0[4 * g + 1] * inv); w0.y = pk2(o0[4 * g + 2] * inv, o0[4 * g + 3] * inv);
            w1.x = pk2(o1[4 * g] * inv, o1[4 * g + 1] * inv); w1.y = pk2(o1[4 * g + 2] * inv, o1[4 * g + 3] * inv);
            *(u32x2*)(u.o + 8 * g + 4 * hi) = w0; *(u32x2*)(u.o + 32 + 8 * g + 4 * hi) = w1;
        }
    }
}

__device__ __forceinline__ int fox_first_tile(const unsigned* nrm, const float* bias, int row0, int ntl, int lane) {
    const float q2 = __uint_as_float(nrm[0]), k2 = __uint_as_float(nrm[1]);
    const float slack = 2.0f * sqrtf(q2 * k2) * 1.01f + FOX_THR - bias[row0];
    const bool skip = (lane < ntl) && (slack + bias[64 * (lane < ntl ? lane : 0) + 63] < 0.f);
    const unsigned long long bal = __ballot(skip);
    const int t0 = __ffsll((long long)~bal) - 1;
    return (~bal == 0ull) ? ntl : (t0 < ntl ? t0 : ntl);
}
__device__ __forceinline__ void attn_fox_p(const KP& p, const Ctx& c, int b, int h, int qb) {
    const int r32 = c.lane & 31; const int pos = 256 * qb + 32 * c.wid + r32; const size_t row = (size_t)b * 4096 + pos;
    FU u; u.q = (const bf16*)(p.ws + WS_FQ) + row * 512 + h * 64; u.kbase = (const bf16*)(p.ws + WS_FKP) + (size_t)b * 4096 * 512 + h * 64; u.vbase = (const bf16*)(p.ws + WS_FVP) + (size_t)b * 4096 * 512 + h * 64;
    u.bias = (const float*)(p.ws + WS_BIASP) + (size_t)(b * 8 + h) * SEQ; u.mask = nullptr; u.o = (bf16*)(p.ws + WS_AO) + row * DM + h * 64;
    u.kvstride = 512; u.ntiles = 4 * qb + 4; u.qpos = pos; u.causal_from = 4 * qb; u.wave_qmax = 256 * qb + 32 * c.wid + 31; u.valid = true;
    u.t_begin = fox_first_tile((const unsigned*)(p.ws + WS_NORM) + (b * 8 + h) * 2, u.bias, 256 * qb, 4 * qb, c.lane);
    flash_unit(u, c);
}
__device__ __forceinline__ void attn_fox_s(const KP& p, const Ctx& c, int b, int h) {
    const int r32 = c.lane & 31; const size_t row = (size_t)MP + b * 32 + r32;
    FU u; u.q = (const bf16*)(p.ws + WS_FQ) + row * 512 + h * 64; u.kbase = (const bf16*)(p.ws + WS_FKA) + (size_t)b * KVS * 512 + h * 64; u.vbase = (const bf16*)(p.ws + WS_FVA) + (size_t)b * KVS * 512 + h * 64;
    u.bias = (const float*)(p.ws + WS_BIASS) + (size_t)(b * 8 + h) * KVS; u.mask = nullptr; u.o = (bf16*)(p.ws + WS_AO) + row * DM + h * 64;
    u.kvstride = 512; u.ntiles = 65; u.qpos = 4096 + r32; u.causal_from = 64; u.wave_qmax = 4127; u.valid = (c.wid == 0);
    u.t_begin = fox_first_tile((const unsigned*)(p.ws + WS_NORM) + ((16 + b) * 8 + h) * 2, u.bias, 4096, 64, c.lane);
    flash_unit(u, c);
}
__device__ __forceinline__ void attn_dsa_p(const KP& p, const Ctx& c, int b, int ch, int g) {
    const int r32 = c.lane & 31; const int hh = 4 * g + (c.wid >> 1); const size_t row = (size_t)b * 4096 + 64 * ch + 32 * (c.wid & 1) + r32;
    FU u; u.q = (const bf16*)(p.ws + WS_DQ) + row * 512 + hh * 64; u.kbase = (const bf16*)(p.ws + WS_DKP) + (size_t)b * 4096 * 128 + g * 64; u.vbase = (const bf16*)(p.ws + WS_DVP) + (size_t)b * 4096 * 128 + g * 64;
    u.bias = nullptr; u.mask = (const unsigned long long*)(p.ws + WS_MASK) + row * MW; u.o = (bf16*)(p.ws + WS_AO) + row * DM + 512 + hh * 64;
    u.kvstride = 128; u.ntiles = ch + 1; u.qpos = 0; u.causal_from = ch + 1; u.wave_qmax = 0; u.valid = true; u.t_begin = 0;
    flash_unit(u, c);
}
__device__ __forceinline__ void attn_dsa_s(const KP& p, const Ctx& c, int b, int g) {
    const int r32 = c.lane & 31; const int hh = 4 * g + (c.wid & 3); const size_t row = (size_t)MP + b * 32 + r32;
    FU u; u.q = (const bf16*)(p.ws + WS_DQ) + row * 512 + hh * 64; u.kbase = (const bf16*)(p.ws + WS_DKA) + (size_t)b * KVS * 128 + g * 64; u.vbase = (const bf16*)(p.ws + WS_DVA) + (size_t)b * KVS * 128 + g * 64;
    u.bias = nullptr; u.mask = (const unsigned long long*)(p.ws + WS_MASK) + row * MW; u.o = (bf16*)(p.ws + WS_AO) + row * DM + 512 + hh * 64;
    u.kvstride = 128; u.ntiles = 65; u.qpos = 0; u.causal_from = 65; u.wave_qmax = 0; u.valid = (c.wid < 4); u.t_begin = 0;
    flash_unit(u, c);
}

__device__ __forceinline__ void ln1_apply(const Ctx& c, const float* z, const float* stats, const float* gam, const float* bet, bf16* outb, float* rowstat) {
    for (int row0 = c.gw; row0 < MT; row0 += 2 * c.ngw) {
        float s[2], q[2]; f32x4 v[2][4];
#pragma unroll
        for (int e = 0; e < 2; ++e) { const int row = row0 + e * c.ngw < MT ? row0 + e * c.ngw : row0;
            s[e] = 0.f; q[e] = 0.f; if (c.lane < 16) { const float* sp = stats + ((size_t)row * 16 + c.lane) * 2; s[e] = sp[0]; q[e] = sp[1]; }
            const float* zr = z + (size_t)row * DM;
#pragma unroll
            for (int j = 0; j < 4; ++j) v[e][j] = *(const f32x4*)(zr + 256 * j + 4 * c.lane); }
#pragma unroll
        for (int e = 0; e < 2; ++e) { const int row = row0 + e * c.ngw; if (row < MT) {
            float ss = s[e], qq = q[e];
            ss = __builtin_amdgcn_readfirstlane(row_sum16(ss)); qq = __builtin_amdgcn_readfirstlane(row_sum16(qq));
            const float mean = ss * (1.f / DM), var = fmaxf(qq * (1.f / DM) - mean * mean, 0.f), rstd = 1.0f / sqrtf(var + LN_EPS);
            if (c.lane == 0) { rowstat[2 * (size_t)row] = mean; rowstat[2 * (size_t)row + 1] = rstd; }
#pragma unroll
            for (int j = 0; j < 4; ++j) { const int col = 256 * j + 4 * c.lane;
                const f32x4 gg = *(const f32x4*)(gam + col), bb = *(const f32x4*)(bet + col);
                const f32x4 o = (v[e][j] - mean) * rstd * gg + bb;
                u32x2 w; w.x = pk2(o[0], o[1]); w.y = pk2(o[2], o[3]); *(u32x2*)(outb + (size_t)row * DM + col) = w; } } }
    }
}
__device__ __forceinline__ void ln2_apply(const Ctx& c, const bf16* z2b, const float* stats, const float* gam, const float* bet, float* outf) {
    for (int row0 = c.gw; row0 < MT; row0 += 2 * c.ngw) {
        float s[2], q[2]; u32x2 v[2][4];
#pragma unroll
        for (int e = 0; e < 2; ++e) { const int row = row0 + e * c.ngw < MT ? row0 + e * c.ngw : row0;
            s[e] = 0.f; q[e] = 0.f; if (c.lane < 16) { const float* sp = stats + ((size_t)row * 16 + c.lane) * 2; s[e] = sp[0]; q[e] = sp[1]; }
            const bf16* zr = z2b + (size_t)row * DM;
#pragma unroll
            for (int j = 0; j < 4; ++j) v[e][j] = *(const u32x2*)(zr + 256 * j + 4 * c.lane); }
#pragma unroll
        for (int e = 0; e < 2; ++e) { const int row = row0 + e * c.ngw; if (row < MT) {
            float ss = s[e], qq = q[e];
            ss = __builtin_amdgcn_readfirstlane(row_sum16(ss)); qq = __builtin_amdgcn_readfirstlane(row_sum16(qq));
            const float mean = ss * (1.f / DM), var = fmaxf(qq * (1.f / DM) - mean * mean, 0.f), rstd = 1.0f / sqrtf(var + LN_EPS);
#pragma unroll
            for (int j = 0; j < 4; ++j) { const int col = 256 * j + 4 * c.lane;
                const f32x4 gg = *(const f32x4*)(gam + col), bb = *(const f32x4*)(bet + col);
                const f32x4 x = (f32x4){__uint_as_float(v[e][j].x << 16), __uint_as_float(v[e][j].x & 0xFFFF0000u), __uint_as_float(v[e][j].y << 16), __uint_as_float(v[e][j].y & 0xFFFF0000u)};
                *(f32x4*)(outf + (size_t)row * DM + col) = (x - mean) * rstd * gg + bb; } } }
    }
}

struct MiniArgs { const bf16* A; const bf16* Bt; int K; const float* xs; float* z; float* stats; bf16* act; const float* rowstat; const float* g1; const float* b1; bf16* z2b; };
template <int MODE> __device__ __forceinline__ void mini_tile(const MiniArgs& a, const Ctx& c, int rt, int ct) {
    const int lane = c.lane, wid = c.wid, r32 = lane & 31, hi = lane >> 5;
    const int row0 = MP + 32 * rt;
    const int brow0 = MODE == 1 ? 256 * (ct >> 2) + 32 * (ct & 3) : 64 * ct, brow1 = MODE == 1 ? brow0 + 128 : brow0 + 32;
    const int K = a.K, nks = K / 16;
    const bf16* ap = a.A + (size_t)(row0 + r32) * K + 8 * hi;
    const bf16* b0p = a.Bt + (size_t)(brow0 + r32) * K + 8 * hi;
    const bf16* b1p = a.Bt + (size_t)(brow1 + r32) * K + 8 * hi;
    f32x16 c0, c1;
#pragma unroll
    for (int r = 0; r < 16; ++r) { c0[r] = 0.f; c1[r] = 0.f; }
    for (int ks0 = wid; ks0 < nks; ks0 += 32) {
        bf16x8 av[4], bv0[4], bv1[4];
#pragma unroll
        for (int u = 0; u < 4; ++u) { const int ks = ks0 + 8 * u; const int kc = ks < nks ? ks : ks0; av[u] = *(const bf16x8*)(ap + 16 * kc); bv0[u] = *(const bf16x8*)(b0p + 16 * kc); bv1[u] = *(const bf16x8*)(b1p + 16 * kc); }
#pragma unroll
        for (int u = 0; u < 4; ++u) if (ks0 + 8 * u < nks) { c0 = __builtin_amdgcn_mfma_f32_32x32x16_bf16(av[u], bv0[u], c0, 0, 0, 0); c1 = __builtin_amdgcn_mfma_f32_32x32x16_bf16(av[u], bv1[u], c1, 0, 0, 0); }
    }
    LAS float* red = (LAS float*)c.lds;
#pragma unroll
    for (int r = 0; r < 16; ++r) { red[((wid * 2 + 0) * 16 + r) * 64 + lane] = c0[r]; red[((wid * 2 + 1) * 16 + r) * 64 + lane] = c1[r]; }
    __syncthreads();
#pragma unroll
    for (int e = 0; e < 2; ++e) {
        const int r = 2 * wid + e; float v0 = 0.f, v1 = 0.f;
#pragma unroll
        for (int w = 0; w < 8; ++w) { v0 += red[((w * 2 + 0) * 16 + r) * 64 + lane]; v1 += red[((w * 2 + 1) * 16 + r) * 64 + lane]; }
        const int row = row0 + (r & 3) + 8 * (r >> 2) + 4 * hi;
        if (MODE == 1) {
            const float g = v0; const float o = g * __builtin_amdgcn_rcpf(1.f + __expf(-g)) * v1;
            a.act[(size_t)row * DFF + 32 * ct + r32] = (bf16)(pk2(o, 0.f) & 0xFFFFu);
        } else {
            const int col = 64 * ct + r32; float z0, z1;
            if (MODE == 0) { const float* xr = a.xs + (size_t)(row - MP) * DM + col; z0 = xr[0] * ALPHA + v0; z1 = xr[32] * ALPHA + v1; float* zr = a.z + (size_t)row * DM + col; zr[0] = z0; zr[32] = z1; }
            else { const float mean = a.rowstat[2 * (size_t)row], rstd = a.rowstat[2 * (size_t)row + 1]; const float* zr = a.z + (size_t)row * DM + col;
                   const float h0 = (zr[0] - mean) * rstd * a.g1[col] + a.b1[col], h1 = (zr[32] - mean) * rstd * a.g1[col + 32] + a.b1[col + 32];
                   z0 = h0 * ALPHA + v0; z1 = h1 * ALPHA + v1; bf16* o = a.z2b + (size_t)row * DM + col; o[0] = (bf16)(pk2(z0, 0.f) & 0xFFFFu); o[32] = (bf16)(pk2(z1, 0.f) & 0xFFFFu); }
            float sm = z0 + z1, sq = z0 * z0 + z1 * z1;
#pragma unroll
            for (int o = 0; o < 1; ++o) { sm = pg8::add_xor16(row_sum16(sm)); sq = pg8::add_xor16(row_sum16(sq)); }
            if (r32 == 0) { float* sp = a.stats + ((size_t)row * 16 + ct) * 2; sp[0] = sm; sp[1] = sq; }
        }
    }
    __syncthreads();
}
template <int MODE> __device__ __forceinline__ void mini_phase(const MiniArgs& a, const Ctx& c, int nct, int G, int bx) {
#pragma unroll 1
    for (int t = bx; t < 8 * nct; t += G) mini_tile<MODE>(a, c, t / nct, t % nct);
}

#ifndef REP_P2
#define REP_P2 1
#endif
#ifndef REP_FOX
#define REP_FOX 1
#endif
#ifndef REP_DSA
#define REP_DSA 1
#endif
constexpr int LDS_BYTES = pg8::STAGE_BYTES;
__global__ void __launch_bounds__(512, 2) fox_dsa_fwd(KP p) {
    extern __shared__ __attribute__((aligned(16))) unsigned char lds_raw[];
    cg::grid_group grid = cg::this_grid();
#define MKCTX() Ctx c; { int t_ = threadIdx.x; asm volatile("" : "+v"(t_)); c.tid = t_; c.lane = t_ & 63; c.wid = __builtin_amdgcn_readfirstlane(t_ >> 6); c.gw = blockIdx.x * 8 + c.wid; c.ngw = gridDim.x * 8; c.lds = (LAS unsigned char*)lds_raw; } \
    const int G = gridDim.x, bx = blockIdx.x; unsigned char* ws = p.ws; (void)G; (void)bx; (void)ws;

    { MKCTX();
    p0_prologue(p, c);
    }
    grid.sync();
    { MKCTX();
    { pg8::Gemm g{(const pg8::bf16_t*)(ws + WS_XB), (const pg8::bf16_t*)(ws + WS_WIN), MT, NIN, DM}; pg8::StaticOrder S; S.init(MT, NIN, G, bx);
      pg8::EpiIn E{p.out, ws, p.b_forget};
      pg8::gemm_phase<pg8::EpiIn, pg8::StaticOrder, true, true>(c.lds, g, S, E); }
    }
    grid.sync();
    { MKCTX();
    if (c.gw < 24) cumsum_item(p, c.gw, c.lane);
    for (int vb = bx; vb < 256; vb += G) {
        { const int bh = vb >> 1, r0 = (vb & 1) * 2048 + c.wid * 256; unsigned* nd = (unsigned*)(ws + WS_NORM) + bh * 2;
          norm_rows((const bf16*)(ws + WS_FQ) + (size_t)(bh >> 3) * 4096 * 512, r0, 256, bh & 7, nd, c.lane);
          norm_rows((const bf16*)(ws + WS_FKP) + (size_t)(bh >> 3) * 4096 * 512, r0, 256, bh & 7, nd + 1, c.lane); }
        if (vb < 64) { const int sb = vb >> 3, h = vb & 7; unsigned* nd = (unsigned*)(ws + WS_NORM) + ((16 + sb) * 8 + h) * 2;
          norm_rows_f32(p.cfk + (size_t)sb * 4096 * 512, c.wid * 512, 512, h, nd + 1, c.lane);
          if (c.wid == 1) norm_rows((const bf16*)(ws + WS_FKA) + (size_t)sb * KVS * 512, 4096, 32, h, nd + 1, c.lane);
          if (c.wid == 0) norm_rows((const bf16*)(ws + WS_FQ) + (size_t)(MP + sb * 32) * 512, 0, 32, h, nd, c.lane); }
    }
    { float* scr = (float*)(ws + WS_SCR) + (size_t)bx * 32 * SCR_LD;
      for (int rep = 0; rep < REP_P2; ++rep) {
      unsigned* qctr = (unsigned*)(ws + WS_NORM) + 1024 - 2 - 2 * rep;
      volatile LAS int* qsh = (volatile LAS int*)(c.lds + 60000);
      for (;;) {
          if (c.tid == 0) *qsh = (int)atomicAdd(qctr, 1u);
          __syncthreads();
          int idx = *qsh;
          __syncthreads();
          if (idx >= 8 + 2048 + 640) break;
          if (idx >= 8 + 2048) { conv_item(p, c, idx - (8 + 2048)); continue; }
          int ub, uc, uh; if (idx < 8) { ub = idx; uc = -1; uh = 0; } else { idx -= 8; ub = (idx & 31) >> 1; uc = 63 - (idx >> 5); uh = idx & 1; }
          idx_unit(p, c, ub, uc, uh, scr);
      } } }
    }
    grid.sync();
    { MKCTX();
      for (int rep = 0; rep < REP_FOX; ++rep) {
      unsigned* qctr = (unsigned*)(ws + WS_NORM) + 1024 - 1 - 2 * rep;
      volatile LAS int* qsh = (volatile LAS int*)(c.lds + 60000);
      for (;;) {
          if (c.tid == 0) *qsh = (int)atomicAdd(qctr, 1u);
          __syncthreads();
          int idx = *qsh;
          __syncthreads();
          if (idx >= 80 + 16 * 256) break;
          if (idx < 16) { attn_dsa_s(p, c, idx >> 1, idx & 1); continue; }
          if (idx < 80) { idx -= 16; attn_fox_s(p, c, idx >> 3, idx & 7); continue; }
          idx -= 80;
          const int k = 15 - (idx >> 8), r = idx & 255;
          if (r < 32) attn_dsa_p(p, c, r >> 1, 4 * k + 3, r & 1);
          else if (r < 160) { const int u = r - 32; attn_fox_p(p, c, u >> 3, u & 7, k); }
          else { const int u = r - 160, lv = u >> 5, w = u & 31; attn_dsa_p(p, c, w >> 1, 4 * k + 2 - lv, w & 1); }
      } }
    }
    grid.sync();
    { MKCTX();
    { MiniArgs ma{}; ma.A = (const bf16*)(ws + WS_AO); ma.Bt = (const bf16*)(ws + WS_WO); ma.K = DM; ma.xs = p.xs; ma.z = (float*)(ws + WS_Z); ma.stats = (float*)(ws + WS_ST1);
      mini_phase<0>(ma, c, 16, G, bx); }
    { pg8::Gemm g{(const pg8::bf16_t*)(ws + WS_AO), (const pg8::bf16_t*)(ws + WS_WO), MP, DM, DM}; pg8::StaticOrder S; S.init(MP, DM, G, bx);
      pg8::EpiZ E{p.xp, p.xs, (float*)(ws + WS_Z), (float*)(ws + WS_ST1)};
      pg8::gemm_phase<pg8::EpiZ, pg8::StaticOrder, true, true>(c.lds, g, S, E); }
    }
    grid.sync();
    { MKCTX();
    ln1_apply(c, (const float*)(ws + WS_Z), (const float*)(ws + WS_ST1), p.ln1g, p.ln1b, (bf16*)(ws + WS_HB), (float*)(ws + WS_RS1));
    }
    grid.sync();
    { MKCTX();
    { MiniArgs ma{}; ma.A = (const bf16*)(ws + WS_HB); ma.Bt = (const bf16*)(ws + WS_WGU); ma.K = DM; ma.act = (bf16*)(ws + WS_ACT);
      mini_phase<1>(ma, c, 88, G, bx); }
    { pg8::Gemm g{(const pg8::bf16_t*)(ws + WS_HB), (const pg8::bf16_t*)(ws + WS_WGU), MP, NGU, DM}; pg8::StaticOrder S; S.init(MP, NGU, G, bx);
      pg8::EpiAct E{(pg8::bf16_t*)(ws + WS_ACT)};
      pg8::gemm_phase<pg8::EpiAct, pg8::StaticOrder, true, true>(c.lds, g, S, E); }
    }
    grid.sync();
    { MKCTX();
    { MiniArgs ma{}; ma.A = (const bf16*)(ws + WS_ACT); ma.Bt = (const bf16*)(ws + WS_WD); ma.K = DFF; ma.z = (float*)(ws + WS_Z); ma.stats = (float*)(ws + WS_ST2);
      ma.rowstat = (const float*)(ws + WS_RS1); ma.g1 = p.ln1g; ma.b1 = p.ln1b; ma.z2b = (bf16*)(ws + WS_Z2B);
      mini_phase<2>(ma, c, 16, G, bx); }
    { pg8::Gemm g{(const pg8::bf16_t*)(ws + WS_ACT), (const pg8::bf16_t*)(ws + WS_WD), MP, DM, DFF}; pg8::StaticOrder S; S.init(MP, DM, G, bx);
      pg8::EpiZ2 E{(const float*)(ws + WS_Z), (const float*)(ws + WS_RS1), p.ln1g, p.ln1b, (pg8::bf16_t*)(ws + WS_Z2B), (float*)(ws + WS_ST2)};
      pg8::gemm_phase<pg8::EpiZ2, pg8::StaticOrder, true, true>(c.lds, g, S, E); }
    }
    grid.sync();
    { MKCTX();
    ln2_apply(c, (const bf16*)(ws + WS_Z2B), (const float*)(ws + WS_ST2), p.ln2g, p.ln2b, p.out);
    }
}

extern "C" void kernel_launch(void* const* d_in, const int* in_sizes, int n_in, void* d_out, int out_size, void* d_ws, size_t ws_size, hipStream_t stream) {
    static int grid = 0;
    if (grid == 0) {
        if (n_in != 18 || (size_t)out_size != O_END || ws_size < WS_NEED) { fprintf(stderr, "kernel_launch: unexpected shapes (n_in %d out %d ws %zu need %zu)\n", n_in, out_size, ws_size, (size_t)WS_NEED); grid = -1; return; }
        int dev = 0, cus = 0, per_cu = 0;
        hipGetDevice(&dev); hipDeviceGetAttribute(&cus, hipDeviceAttributeMultiprocessorCount, dev);
        hipFuncSetAttribute((const void*)fox_dsa_fwd, hipFuncAttributeMaxDynamicSharedMemorySize, LDS_BYTES);
        if (hipOccupancyMaxActiveBlocksPerMultiprocessor(&per_cu, (const void*)fox_dsa_fwd, 512, LDS_BYTES) != hipSuccess || per_cu < 1) per_cu = 1;
        (void)hipGetLastError();
        grid = cus * 1;
        if (grid > 256) grid = 256;
    }
    if (grid < 0) return;
    KP p{};
    p.xp = (const float*)d_in[0]; p.xs = (const float*)d_in[1]; p.cfk = (const float*)d_in[2]; p.cfv = (const float*)d_in[3]; p.cflf = (const float*)d_in[4];
    p.cdk = (const float*)d_in[5]; p.cdv = (const float*)d_in[6]; p.cik = (const float*)d_in[7]; p.w_in = (const float*)d_in[8]; p.b_forget = (const float*)d_in[9];
    p.w_out = (const float*)d_in[10]; p.ln1g = (const float*)d_in[11]; p.ln1b = (const float*)d_in[12]; p.w_gate = (const float*)d_in[13]; p.w_up = (const float*)d_in[14];
    p.w_down = (const float*)d_in[15]; p.ln2g = (const float*)d_in[16]; p.ln2b = (const float*)d_in[17]; p.out = (float*)d_out; p.ws = (unsigned char*)d_ws;
    void* args[] = {&p};
    hipError_t e = hipLaunchCooperativeKernel((const void*)fox_dsa_fwd, dim3(grid), dim3(512), args, LDS_BYTES, stream);
    if (e != hipSuccess) fprintf(stderr, "cooperative launch failed: %s (grid %d)\n", hipGetErrorString(e), grid);
}
```
